# Optimizing an MI355X kernel written in HIP

```python
import math
import jax
import jax.numpy as jnp
from jax import lax
import numpy as np

D_MODEL = 2048
BATCH = 8
SEQ = 4096
DEPTH = 4

N_MIXERS = 4
GROUP_WIDTH = D_MODEL // N_MIXERS
HEAD_DIM = 128
N_HEADS = GROUP_WIDTH // HEAD_DIM
MIX_WIDTH = N_MIXERS * GROUP_WIDTH
Q_LORA = 512
KV_LORA = 512
QK_NOPE = 128
QK_ROPE = 64
V_HEAD = HEAD_DIM
MLA_QK_DIM = QK_NOPE + QK_ROPE
DILATED_PAIRS = ((128, 1), (512, 4), (2048, 16))
FORGET_BIAS_INIT = 2.0
BLOCK = 128
ROPE_THETA = 10000.0
FFN_HIDDEN = -(-8 * D_MODEL // (3 * 256)) * 256
EPS = 1e-6
NEG_INF = -1e30
IN_SPLITS = ((Q_LORA, KV_LORA, QK_ROPE)
             + (GROUP_WIDTH,) * 3
             + (GROUP_WIDTH,) * 3 + (N_HEADS,)
             + (GROUP_WIDTH,) * 3)
IN_WIDTH = sum(IN_SPLITS)

kernel_name = "hybrid_parallel_heads_mla_dilated_fox_stickbreak"


def rms_norm(x, gain):
    xf = x.astype(jnp.float32)
    y = xf * lax.rsqrt(jnp.mean(jnp.square(xf), axis=-1, keepdims=True) + EPS)
    return (y * gain.astype(jnp.float32)).astype(x.dtype)


def rope_tables(seq, dim):
    pos = jnp.arange(seq, dtype=jnp.float32)
    inv_freq = ROPE_THETA ** (-jnp.arange(0, dim, 2, dtype=jnp.float32) / dim)
    ang = pos[:, None] * inv_freq[None, :]
    return jnp.cos(ang), jnp.sin(ang)


def apply_rope(x, cos, sin):
    xf = x.astype(jnp.float32)
    x1, x2 = jnp.split(xf, 2, axis=-1)
    c, s = cos[:, None, :], sin[:, None, :]
    return jnp.concatenate([x1 * c - x2 * s, x1 * s + x2 * c], axis=-1).astype(x.dtype)


def split_heads(t):
    b, s, _ = t.shape
    return t.reshape(b, s, N_HEADS, -1)


def to_query_blocks(t):
    b, h, s = t.shape[:3]
    t = t.reshape((b, h, s // BLOCK, BLOCK) + t.shape[3:])
    return jnp.moveaxis(t, 2, 0)


def from_query_blocks(o):
    nb, b, h, _, d = o.shape
    return jnp.moveaxis(o, 0, 2).reshape(b, h, nb * BLOCK, d).transpose(0, 2, 1, 3)


def causal_softmax_attention(q, k, v, scale, cum_log_forget=None):
    s_len = q.shape[1]
    qh, kh, vh = (t.transpose(0, 2, 1, 3) for t in (q, k, v))
    key_pos = jnp.arange(s_len)
    block_idx = jnp.arange(s_len // BLOCK)
    if cum_log_forget is None:
        xs = (to_query_blocks(qh), block_idx)
    else:
        xs = (to_query_blocks(qh), block_idx, to_query_blocks(cum_log_forget))

    def body(args):
        qi, i = args[0], args[1]
        s = jnp.einsum('bhqd,bhkd->bhqk', qi, kh).astype(jnp.float32) * scale
        if cum_log_forget is not None:
            s = s + args[2][..., None] - cum_log_forget[:, :, None, :]
        q_pos = i * BLOCK + jnp.arange(BLOCK)
        s = jnp.where(key_pos[None, :] <= q_pos[:, None], s, NEG_INF)
        p = jax.nn.softmax(s, axis=-1).astype(vh.dtype)
        return jnp.einsum('bhqk,bhkd->bhqd', p, vh)

    return from_query_blocks(lax.map(body, xs))


def mla_attention(q_lat, kv_lat, k_rope, q_norm, w_uq, kv_norm, w_ukv, cos, sin):
    b, s, _ = q_lat.shape
    q = (rms_norm(q_lat, q_norm) @ w_uq).reshape(b, s, N_HEADS, MLA_QK_DIM)
    q = jnp.concatenate([q[..., :QK_NOPE], apply_rope(q[..., QK_NOPE:], cos, sin)], axis=-1)
    kv = (rms_norm(kv_lat, kv_norm) @ w_ukv).reshape(b, s, N_HEADS, QK_NOPE + V_HEAD)
    k_nope, v = kv[..., :QK_NOPE], kv[..., QK_NOPE:]
    k_pe = apply_rope(k_rope[:, :, None, :], cos, sin)
    k = jnp.concatenate([k_nope, jnp.broadcast_to(k_pe, (b, s, N_HEADS, QK_ROPE))], axis=-1)
    return causal_softmax_attention(q, k, v, MLA_QK_DIM ** -0.5)


def banded_window_attention(q, k, v, steps, scale):
    n, h, l, d = q.shape
    pad = (-l) % BLOCK
    cfg = ((0, 0), (0, 0), (0, pad), (0, 0))
    q, k, v = jnp.pad(q, cfg), jnp.pad(k, cfg), jnp.pad(v, cfg)
    nb = (l + pad) // BLOCK
    qb = q.reshape(n, h, nb, BLOCK, d)

    def with_prev(t):
        tb = t.reshape(n, h, nb, BLOCK, d)
        prev = jnp.concatenate([jnp.zeros_like(tb[:, :, :1]), tb[:, :, :-1]], axis=2)
        return jnp.concatenate([prev, tb], axis=3)

    kb, vb = with_prev(k), with_prev(v)
    s = jnp.einsum('nhbqd,nhbkd->nhbqk', qb, kb).astype(jnp.float32) * scale
    q_idx = jnp.arange(BLOCK)
    k_idx = jnp.arange(2 * BLOCK)
    dist = BLOCK + q_idx[:, None] - k_idx[None, :]
    key_pos = (jnp.arange(nb)[:, None] - 1) * BLOCK + k_idx[None, :]
    valid = ((dist >= 0) & (dist <= steps))[None] & (key_pos >= 0)[:, None, :]
    s = jnp.where(valid, s, NEG_INF)
    lse = jax.nn.logsumexp(s, axis=-1)
    p = jnp.exp(s - lse[..., None]).astype(v.dtype)
    out = jnp.einsum('nhbqk,nhbkd->nhbqd', p, vb).reshape(n, h, nb * BLOCK, d)[:, :, :l]
    return out, lse.reshape(n, h, nb * BLOCK)[:, :, :l]


def dilated_window_attention(q, k, v):
    b, s, h, d = q.shape
    scale = d ** -0.5
    outs, lses = [], []
    for window, dilation in DILATED_PAIRS:
        l = s // dilation

        def by_residue(t):
            return t.reshape(b, l, dilation, h, d).transpose(0, 2, 3, 1, 4).reshape(b * dilation, h, l, d)

        o, lse = banded_window_attention(by_residue(q), by_residue(k), by_residue(v),
                                         window // dilation, scale)
        outs.append(o.reshape(b, dilation, h, l, d).transpose(0, 3, 1, 2, 4).reshape(b, s, h, d))
        lses.append(lse.reshape(b, dilation, h, l).transpose(0, 3, 1, 2).reshape(b, s, h))
    weights = jax.nn.softmax(jnp.stack(lses), axis=0).astype(q.dtype)
    return jnp.einsum('gbsh,gbshd->bshd', weights, jnp.stack(outs))


def forgetting_attention(q, k, v, f_logit, f_bias):
    log_f = jax.nn.log_sigmoid((f_logit + f_bias).astype(jnp.float32))
    cum = jnp.cumsum(log_f, axis=1).transpose(0, 2, 1)
    return causal_softmax_attention(q, k, v, HEAD_DIM ** -0.5, cum)


def stick_breaking_attention(q, k, v):
    s_len, d = q.shape[1], q.shape[-1]
    scale = d ** -0.5
    qh, kh, vh = (t.transpose(0, 2, 1, 3) for t in (q, k, v))
    key_pos = jnp.arange(s_len)

    def body(args):
        qi, i = args
        z = jnp.einsum('bhqd,bhkd->bhqk', qi, kh).astype(jnp.float32) * scale
        q_pos = i * BLOCK + jnp.arange(BLOCK)
        past = key_pos[None, :] < q_pos[:, None]
        log_keep = jnp.where(past, jax.nn.log_sigmoid(-z), 0.0)
        between = lax.cumsum(log_keep, axis=3, reverse=True) - log_keep
        a = jnp.where(past, jnp.exp(jax.nn.log_sigmoid(z) + between), 0.0)
        return jnp.einsum('bhqk,bhkd->bhqd', a.astype(vh.dtype), vh)

    xs = (to_query_blocks(qh), jnp.arange(s_len // BLOCK))
    return from_query_blocks(lax.map(body, xs))


def hybrid_mixer(h, w_in, mla_q_norm, w_uq, mla_kv_norm, w_ukv, fox_forget_bias,
                 group_norm, w_out, rope_full, rope_mla):
    b, s, _ = h.shape
    proj = h @ w_in
    offsets = np.cumsum(IN_SPLITS)[:-1].tolist()
    (q_lat, kv_lat, k_rope, q_b, k_b, v_b, q_c, k_c, v_c, f_c, q_d, k_d, v_d) = \
        jnp.split(proj, offsets, axis=-1)
    cos, sin = rope_full
    out_a = mla_attention(q_lat, kv_lat, k_rope, mla_q_norm, w_uq, mla_kv_norm, w_ukv, *rope_mla)
    out_b = dilated_window_attention(apply_rope(split_heads(q_b), cos, sin),
                                     apply_rope(split_heads(k_b), cos, sin), split_heads(v_b))
    out_c = forgetting_attention(split_heads(q_c), split_heads(k_c), split_heads(v_c),
                                 f_c, fox_forget_bias)
    out_d = stick_breaking_attention(split_heads(q_d), split_heads(k_d), split_heads(v_d))
    groups = jnp.stack([o.reshape(b, s, GROUP_WIDTH) for o in (out_a, out_b, out_c, out_d)],
                       axis=2)
    groups = rms_norm(groups, group_norm.reshape(N_MIXERS, GROUP_WIDTH))
    return groups.reshape(b, s, MIX_WIDTH) @ w_out


def setup_inputs(seed: int = 0) -> dict:
    key = jax.random.key(seed)
    ks = jax.random.split(key, 16)

    def w(k, shape, fan_in):
        return jax.random.normal(k, shape, jnp.float32) * fan_in ** -0.5

    def gain(k, shape):
        return 1.0 + 0.05 * jax.random.normal(k, shape, jnp.float32)

    return {
        "x": jax.random.normal(ks[0], (BATCH, SEQ, D_MODEL), jnp.float32),
        "attn_norm": gain(ks[1], (DEPTH, D_MODEL)),
        "w_in": w(ks[2], (DEPTH, D_MODEL, IN_WIDTH), D_MODEL),
        "mla_q_norm": gain(ks[3], (DEPTH, Q_LORA)),
        "w_uq": w(ks[4], (DEPTH, Q_LORA, N_HEADS * MLA_QK_DIM), Q_LORA),
        "mla_kv_norm": gain(ks[5], (DEPTH, KV_LORA)),
        "w_ukv": w(ks[6], (DEPTH, KV_LORA, N_HEADS * (QK_NOPE + V_HEAD)), KV_LORA),
        "fox_forget_bias": FORGET_BIAS_INIT + 0.1 * jax.random.normal(ks[7], (DEPTH, N_HEADS), jnp.float32),
        "group_norm": gain(ks[8], (DEPTH, MIX_WIDTH)),
        "w_out": w(ks[9], (DEPTH, MIX_WIDTH, D_MODEL), MIX_WIDTH),
        "ffn_norm": gain(ks[10], (DEPTH, D_MODEL)),
        "w_gate": w(ks[11], (DEPTH, D_MODEL, FFN_HIDDEN), D_MODEL),
        "w_up": w(ks[12], (DEPTH, D_MODEL, FFN_HIDDEN), D_MODEL),
        "w_down": w(ks[13], (DEPTH, FFN_HIDDEN, D_MODEL), FFN_HIDDEN),
        "final_norm": gain(ks[14], (D_MODEL,)),
    }


def reference(x, attn_norm, w_in, mla_q_norm, w_uq, mla_kv_norm, w_ukv, fox_forget_bias,
              group_norm, w_out, ffn_norm, w_gate, w_up, w_down, final_norm):
    s_len = x.shape[1]
    rope_full = rope_tables(s_len, HEAD_DIM)
    rope_mla = rope_tables(s_len, QK_ROPE)
    for l in range(DEPTH):
        x = x + hybrid_mixer(rms_norm(x, attn_norm[l]), w_in[l], mla_q_norm[l], w_uq[l],
                             mla_kv_norm[l], w_ukv[l], fox_forget_bias[l], group_norm[l],
                             w_out[l], rope_full, rope_mla)
        h = rms_norm(x, ffn_norm[l])
        x = x + (jax.nn.silu(h @ w_gate[l]) * (h @ w_up[l])) @ w_down[l]
    return rms_norm(x, final_norm)
```

```cpp
#include <hip/hip_runtime.h>
#include <hip/hip_bf16.h>
#include <cstdio>
#include <cstdint>
#include <cmath>

#ifndef MK_PER_PHASE_LAUNCH
#define MK_PER_PHASE_LAUNCH 0
#endif

constexpr float EPS = 1e-6f;
typedef unsigned long long u64;
constexpr float SS_FIX = 1048576.0f, SS_UNFIX = 1.0f / 1048576.0f;
__device__ __forceinline__ void ss_add(u64* p, float v) { __hip_atomic_fetch_add(p, (u64)(v * SS_FIX + 0.5f), __ATOMIC_RELAXED, __HIP_MEMORY_SCOPE_AGENT); }
__device__ __forceinline__ float ss_get(const u64* p) { return (float)__hip_atomic_load(p, __ATOMIC_RELAXED, __HIP_MEMORY_SCOPE_AGENT) * SS_UNFIX; }
namespace pg8 {
#define PG8_LAS __attribute__((address_space(3)))
typedef unsigned short bf16_t;
typedef short bf16x8 __attribute__((ext_vector_type(8)));
typedef float f32x4 __attribute__((ext_vector_type(4)));
typedef float f32x2 __attribute__((ext_vector_type(2)));
typedef unsigned u32x4 __attribute__((ext_vector_type(4)));
constexpr int BM = 256, BK = 64, HALF = 128, HTB = HALF * BK * 2, STAGE_BYTES = 8 * HTB, NXCD = 8, WGM = 8;

__host__ __device__ __forceinline__ int lds_byte(int r, int c) { const int st = (r >> 4) * 2 + (c >> 5), rr = r & 15, cc = c & 31, ob = rr * 64 + cc * 2; return st * 1024 + (ob ^ (((ob >> 9) & 1) << 5)); }
__host__ __device__ __forceinline__ void stage_rc(int b, int& R, int& C) { const int st = b / 1024, sb = b % 1024, swz = sb ^ (((sb >> 9) & 1) << 5); R = (st >> 1) * 16 + swz / 64; C = (st & 1) * 32 + (swz % 64) / 2; }
__host__ __device__ __forceinline__ int perm32(int rho) { const int n = rho >> 4, i = rho & 15; return 8 * (i >> 2) + 4 * n + (i & 3); }

struct Unit { int pm, pn; };
struct Gemm { const bf16_t* A; const bf16_t* Bt; int M, N, K, lda, a_split_pn, a_split_off; };

struct StaticOrder {
    int nM, nN, nwg, G, c;
    __host__ __device__ void init(int M, int N, int G_, int c_) { nM = M / BM; nN = N / BM; nwg = nM * nN; G = G_; c = c_; }
    __host__ __device__ __forceinline__ bool next(int i, Unit& u) const {
        const long L = (long)i * G + c; if (L >= nwg) return false;
        int wgid = (int)L; { const int q = nwg / NXCD, r = nwg % NXCD, xcd = wgid % NXCD, off = wgid / NXCD; wgid = (xcd < r ? xcd * (q + 1) : r * (q + 1) + (xcd - r) * q) + off; }
        const int nig = WGM * nN, gid = wgid / nig, fm = gid * WGM, gsz = (nM - fm) < WGM ? (nM - fm) : WGM;
        u.pm = fm + ((wgid % nig) % gsz); u.pn = (wgid % nig) / gsz; return true;
    }
};

struct UpOrder {
    int G, c;
    __host__ __device__ __forceinline__ bool next(int i, Unit& u) const {
        if (G == 256) { const int xcd = c & 7, rank = c >> 3, n = rank < 16 ? 2 : 5, first = rank < 16 ? 2 * rank : 32 + 5 * (rank - 16);
            if (i >= n) return false; const int j = first + i; u.pm = 16 * xcd + j / 7; u.pn = j % 7; return true; }
        const long L = (long)i * G + c; if (L >= 896) return false; u.pm = (int)(L / 7); u.pn = (int)(L % 7); return true;
    }
};

__device__ __forceinline__ unsigned cvt_pk_bf16(float lo, float hi) { unsigned r; asm volatile("v_cvt_pk_bf16_f32 %0, %1, %2" : "=v"(r) : "v"(lo), "v"(hi)); return r; }

template <class Epi, bool ALIGN_EPI, bool REVK = false, class Order = StaticOrder>
__device__ __forceinline__ void gemm_phase(PG8_LAS unsigned char* lds, const Gemm g, const Order& S, const Epi& E) {
    int tid = threadIdx.x; asm volatile("" : "+v"(tid));
    const int wid = __builtin_amdgcn_readfirstlane(tid >> 6), lane = tid & 63, wr = wid >> 2, wc = wid & 3, fr = lane & 15, fq = lane >> 4;
    const int K = g.K, nt = K / BK, lda = g.lda;
    unsigned voffA[2], voffB[2];
#pragma unroll
    for (int i = 0; i < 2; ++i) { int R, C; stage_rc(tid * 16 + i * 8192, R, C); const int Rb = Epi::PERM ? ((R & ~31) + perm32(R & 31)) : R;
        voffA[i] = (unsigned)(R * lda + C) * 2u; voffB[i] = (unsigned)(Rb * K + C) * 2u; }
    const long kstep = REVK ? -(long)(BK * 2) : (long)(BK * 2); const size_t k0off = REVK ? (size_t)(nt - 1) * (BK * 2) : (size_t)0;
    const size_t hstepA = (size_t)HALF * lda * 2, hstepB = (size_t)HALF * K * 2;
    const size_t tstepA = 2 * hstepA, tstepB = 2 * hstepB;
    const unsigned ldsw = (unsigned)wid * 1024u;
    const int aoff = lds_byte(wr * 64 + fr, fq * 8), boff = lds_byte(wc * 32 + fr, fq * 8);
#define PG8_AOF(u) ((const char*)g.A + k0off + (size_t)(u).pm * tstepA + ((u).pn >= g.a_split_pn ? (size_t)g.a_split_off * 2 : (size_t)0))
#define PG8_BOF(u) ((const char*)g.Bt + k0off + (size_t)(u).pn * tstepB)
#define PG8_SA(b, h) (((b) * 2 + (h)) * HTB)
#define PG8_SB(b, h) ((4 + (b) * 2 + (h)) * HTB)
#define PG8_STAGE(bufoff, gbase, voff) do { _Pragma("unroll") for (int _i = 0; _i < 2; ++_i) \
        __builtin_amdgcn_global_load_lds((const unsigned*)((const char*)(gbase) + (voff)[_i]), (PG8_LAS unsigned*)(lds + (bufoff) + ldsw + _i * 8192), 16, 0, 0); } while (0)
#define PG8_LDA(dst, b, h) do { _Pragma("unroll") for (int m = 0; m < 4; ++m) _Pragma("unroll") for (int k = 0; k < 2; ++k) dst[m][k] = *(const PG8_LAS bf16x8*)(lds + PG8_SA(b, h) + aoff + m * 2048 + k * 1024); } while (0)
#define PG8_LDB(dst, b, h) do { _Pragma("unroll") for (int n = 0; n < 2; ++n) _Pragma("unroll") for (int k = 0; k < 2; ++k) dst[n][k] = *(const PG8_LAS bf16x8*)(lds + PG8_SB(b, h) + boff + n * 2048 + k * 1024); } while (0)
#define PG8_MMA(ai, bj, At, Bt) do { __builtin_amdgcn_s_setprio(1); _Pragma("unroll") for (int m = 0; m < 4; ++m) _Pragma("unroll") for (int n = 0; n < 2; ++n) _Pragma("unroll") for (int k = 0; k < 2; ++k) \
        acc[ai][bj][m][n] = __builtin_amdgcn_mfma_f32_16x16x32_bf16(Bt[n][k], At[m][k], acc[ai][bj][m][n], 0, 0, 0); __builtin_amdgcn_s_setprio(0); } while (0)
#define PG8_WAIT_V(n) asm volatile("s_waitcnt vmcnt(" #n ")" ::: "memory")
#define PG8_WAIT_L(n) asm volatile("s_waitcnt lgkmcnt(" #n ")" ::: "memory")
#define PG8_BAR __builtin_amdgcn_s_barrier()
#define PG8_SCHED __builtin_amdgcn_sched_barrier(0)
    Unit cur, nxt; int ui = 0;
    if (!S.next(0, cur)) return;
    PG8_LAS float* rtab = (PG8_LAS float*)(lds + STAGE_BYTES);
    if constexpr (Epi::ROWS) { if (tid < 256) rtab[tid] = Epi::RS_MUL / sqrtf(ss_get(E.row_ss(cur) + cur.pm * 256 + tid) * Epi::RS_INV + EPS); }
    f32x4 acc[2][2][4][2];
    { float z = 0.f; asm volatile("" : "+v"(z));
#pragma unroll
    for (int a = 0; a < 2; ++a)
#pragma unroll
        for (int b = 0; b < 2; ++b)
#pragma unroll
            for (int m = 0; m < 4; ++m)
#pragma unroll
                for (int n = 0; n < 2; ++n) acc[a][b][m][n] = (f32x4){z, z, z, z}; }
    bf16x8 At[4][2], B0[2][2], B1[2][2];
    const char* cA = PG8_AOF(cur); const char* cB = PG8_BOF(cur);
    PG8_STAGE(PG8_SB(0, 0), cB, voffB); PG8_STAGE(PG8_SB(0, 1), cB + hstepB, voffB); PG8_STAGE(PG8_SA(0, 0), cA, voffA); PG8_STAGE(PG8_SA(0, 1), cA + hstepA, voffA);
    if (wr == 1) PG8_BAR;
    PG8_WAIT_V(2); PG8_BAR;
    PG8_STAGE(PG8_SB(1, 0), cB + kstep, voffB); PG8_STAGE(PG8_SA(1, 0), cA + kstep, voffA); PG8_STAGE(PG8_SB(1, 1), cB + hstepB + kstep, voffB);
    PG8_WAIT_V(6); PG8_BAR;
    for (;;) {
        const bool has_next = S.next(ui + 1, nxt);
        const char* nA = has_next ? PG8_AOF(nxt) : cA; const char* nB = has_next ? PG8_BOF(nxt) : cB;
        for (int t = 0; t < nt; t += 2) {
            const bool last = (t == nt - 2);
            const char* a1 = cA + (long)(t + 1) * kstep;
            const char* a2 = last ? nA : cA + (long)(t + 2) * kstep; const char* b2 = last ? nB : cB + (long)(t + 2) * kstep;
            const char* a3 = a2 + kstep; const char* b3 = b2 + kstep;
            PG8_LDB(B0, 0, 0); PG8_LDB(B1, 0, 1); PG8_SCHED; PG8_LDA(At, 0, 0); PG8_STAGE(PG8_SA(1, 1), a1 + hstepA, voffA);
            PG8_WAIT_V(8); PG8_WAIT_L(0); PG8_BAR; PG8_MMA(0, 0, At, B0); PG8_MMA(0, 1, At, B1); PG8_BAR; PG8_SCHED;
            PG8_LDA(At, 0, 1); PG8_STAGE(PG8_SB(0, 0), b2, voffB); PG8_STAGE(PG8_SB(0, 1), b2 + hstepB, voffB); PG8_STAGE(PG8_SA(0, 0), a2, voffA);
            PG8_WAIT_V(8); PG8_WAIT_L(0); PG8_BAR; PG8_MMA(1, 0, At, B0); PG8_MMA(1, 1, At, B1); PG8_BAR; PG8_SCHED;
            PG8_LDB(B0, 1, 0); PG8_LDB(B1, 1, 1); PG8_SCHED; PG8_LDA(At, 1, 0); PG8_STAGE(PG8_SA(0, 1), a2 + hstepA, voffA);
            PG8_WAIT_V(8); PG8_WAIT_L(0); PG8_BAR; PG8_MMA(0, 0, At, B0); PG8_MMA(0, 1, At, B1); PG8_BAR; PG8_SCHED;
            PG8_LDA(At, 1, 1); PG8_STAGE(PG8_SB(1, 0), b3, voffB); PG8_STAGE(PG8_SB(1, 1), b3 + hstepB, voffB); PG8_STAGE(PG8_SA(1, 0), a3, voffA);
            PG8_WAIT_V(8); PG8_WAIT_L(0); PG8_BAR; PG8_MMA(1, 0, At, B0); PG8_MMA(1, 1, At, B1); PG8_BAR; PG8_SCHED;
        }
        if constexpr (ALIGN_EPI) { if (wr == 0) PG8_BAR; }
        if constexpr (Epi::ROWS) {
            float nss_ = 0.f; if (has_next && tid < 256) nss_ = ss_get(E.row_ss(nxt) + nxt.pm * 256 + tid);
            E(acc, cur, wr, wc, fr, fq, rtab + (ui & 1) * 256);
            if (has_next && tid < 256) rtab[((ui + 1) & 1) * 256 + tid] = Epi::RS_MUL / sqrtf(nss_ * Epi::RS_INV + EPS);
        } else E(acc, cur, wr, wc, fr, fq);
        if (!has_next) break;
        { float z = 0.f; asm volatile("" : "+v"(z));
#pragma unroll
        for (int a = 0; a < 2; ++a)
#pragma unroll
            for (int b = 0; b < 2; ++b)
#pragma unroll
                for (int m = 0; m < 4; ++m)
#pragma unroll
                    for (int n = 0; n < 2; ++n) acc[a][b][m][n] = (f32x4){z, z, z, z}; }
        cur = nxt; cA = nA; cB = nB; ++ui;
        if constexpr (ALIGN_EPI) { if (wr == 1) PG8_BAR; }
    }
    PG8_WAIT_V(0);
    if constexpr (!ALIGN_EPI) { if (wr == 0) PG8_BAR; }
    PG8_BAR;
#undef PG8_AOF
#undef PG8_BOF
#undef PG8_SA
#undef PG8_SB
#undef PG8_STAGE
#undef PG8_LDA
#undef PG8_LDB
#undef PG8_MMA
#undef PG8_WAIT_V
#undef PG8_WAIT_L
#undef PG8_BAR
#undef PG8_SCHED
}
}

constexpr int NB = 8, SEQ = 4096, DM = 2048, DEPTH = 4, M = NB * SEQ;
constexpr int PW = 5888;
constexpr int IN_W = 5700, FFN = 5632, UPW = 1792;
constexpr int PC_QLAT = 0, PC_KVLAT = 512, PC_KROPE = 1024, PC_FC = 1088, PC_PAD0 = 1092, PC_QB = 1280, PC_KB = 1792, PC_VB = 2304,
              PC_QC = 2816, PC_KC = 3328, PC_VC = 3840, PC_QD = 4352, PC_KD = 4864, PC_VD = 5376;
constexpr size_t WB_IN = 0, WB_UP = WB_IN + (size_t)PW * DM, WB_OUT = WB_UP + (size_t)UPW * 512, WB_GU = WB_OUT + (size_t)DM * DM,
                 WB_DN = WB_GU + (size_t)2 * FFN * DM, WB_END = WB_DN + (size_t)DM * FFN;
constexpr size_t MiB = 1u << 20;
constexpr size_t WS_CTL = 0;
constexpr size_t WS_SS = 1 * MiB;
constexpr size_t CTL_ZERO_BYTES = 6 * MiB;
constexpr size_t WS_CS128 = 6 * MiB;
constexpr size_t WS_CS64 = 8 * MiB;
constexpr size_t WS_KBIAS = 9 * MiB;
constexpr size_t WS_FC = 9 * MiB + 512 * 1024;
constexpr size_t WS_WB = 10 * MiB;
constexpr size_t WS_XB = 114 * MiB;
constexpr size_t WS_PROJ = 242 * MiB;
constexpr size_t WS_MLA = 610 * MiB;
constexpr size_t WS_Y = 722 * MiB;
constexpr size_t WS_WB1 = 850 * MiB;
constexpr size_t WS_XL = 954 * MiB;
constexpr size_t WS_LSE = 1018 * MiB;
constexpr size_t WS_END = 1019 * MiB;
static_assert(WS_SS + (size_t)17 * M * 8 <= CTL_ZERO_BYTES && WS_WB + WB_END * 2 <= WS_XB && WS_XB + (size_t)M * DM * 2 <= WS_PROJ && WS_PROJ + (size_t)M * PW * 2 <= WS_MLA && WS_MLA + (size_t)M * UPW * 2 <= WS_Y && WS_Y + (size_t)M * DM * 2 <= WS_WB1 && WS_WB1 + WB_END * 2 <= WS_XL && WS_XL + (size_t)M * DM <= WS_END, "ws map");
constexpr int CW_BAR = 4096;
constexpr int CW_ATTQ = 16384;
constexpr int CW_FDN = 81920;
constexpr int CW_GNC = 65536;
constexpr int CW_KMAX = 49152;
constexpr int CW_LAT = 90112;
constexpr int CW_SCN = 94208;
constexpr int CW_CVTQ = 32768;

constexpr int RING_BYTES = 131072, LDS_BYTES = 147456, LDSCTL_OFF = LDS_BYTES - 1024, MISC_OFF = LDSCTL_OFF + 320;

#define GAS __attribute__((address_space(1)))
#define LAS __attribute__((address_space(3)))
typedef unsigned short bf16;
typedef unsigned v4u __attribute__((ext_vector_type(4)));
typedef unsigned v2u __attribute__((ext_vector_type(2)));
typedef float f32x4 __attribute__((ext_vector_type(4)));
typedef float f32x2 __attribute__((ext_vector_type(2)));
typedef short bf16x8 __attribute__((ext_vector_type(8)));
typedef GAS unsigned gu32;
#define RLX_AGENT __ATOMIC_RELAXED, __HIP_MEMORY_SCOPE_AGENT
#define LDS_WAIT() asm volatile("s_waitcnt lgkmcnt(0)" ::: "memory")
#define VM_WAIT() asm volatile("s_waitcnt vmcnt(0)" ::: "memory")
__device__ __forceinline__ unsigned f2bf(float f) { unsigned u = __builtin_bit_cast(unsigned, f); return (u + 0x7fffu + ((u >> 16) & 1u)) >> 16; }
__device__ __forceinline__ unsigned pk2(float lo, float hi) { return f2bf(lo) | (f2bf(hi) << 16); }
__device__ __forceinline__ float bflo(unsigned w) { return __builtin_bit_cast(float, w << 16); }
__device__ __forceinline__ float bfhi(unsigned w) { return __builtin_bit_cast(float, w & 0xffff0000u); }
__device__ __forceinline__ void st16_wt(void* p, v4u w) { asm volatile("global_store_dwordx4 %0, %1, off sc1\n\ts_nop 1" :: "v"(p), "v"(w) : "memory"); }

constexpr float RES_TRUNC_GAIN = 1.0028206f;
template <int T> __device__ __forceinline__ float res_join(unsigned hi, unsigned ext) {
    return __uint_as_float(__builtin_amdgcn_perm(hi, ext, ((T & 1) ? 0x07060000u : 0x05040000u) | ((unsigned)T << 8) | 0x0Cu));
}
__device__ __forceinline__ void res_split4(float a, float b, float c, float d, unsigned& w0, unsigned& w1, unsigned& ext) {
    const unsigned ua = __float_as_uint(a), ub = __float_as_uint(b), uc = __float_as_uint(c), ud = __float_as_uint(d);
    w0 = __builtin_amdgcn_perm(ub, ua, 0x07060302u); w1 = __builtin_amdgcn_perm(ud, uc, 0x07060302u);
    ext = __builtin_amdgcn_perm(ub, ua, 0x0C0C0501u) | __builtin_amdgcn_perm(ud, uc, 0x05010C0Cu);
}
__device__ __forceinline__ int xl_idx(int c) { return (c & ~255) | (((c >> 5) & 3) << 6) | (((c >> 3) & 3) << 4) | (((c >> 7) & 1) << 3) | (c & 7); }
struct EpiProj {
    static constexpr bool PERM = true, ROWS = true; static constexpr float RS_INV = 1.0f / 2048.0f, RS_MUL = RES_TRUNC_GAIN;
    __device__ __forceinline__ const u64* row_ss(const pg8::Unit&) const { return ss; }
    bf16* O; const u64* ss; const f32x2* cs128; const f32x2* cs64; u64* ssq; u64* sskv; float* fc; unsigned* latc;
    __device__ __forceinline__ void operator()(const pg8::f32x4 (&acc)[2][2][4][2], const pg8::Unit& u, int wr, int wc, int fr, int fq, const PG8_LAS float* rt) const {
        const int row0 = u.pm * 256 + wr * 64 + fr, ct = wc * 32 + 8 * fq;
        const bool rope_b = (u.pn >= 5 && u.pn <= 8);
        const bool rope_a = (u.pn == 4) && (ct < 64);
#pragma unroll
        for (int ai = 0; ai < 2; ++ai)
#pragma unroll
            for (int m = 0; m < 4; ++m) {
                const int r = row0 + ai * 128 + m * 16; const int pos = r & (SEQ - 1); const float rs = rt[wr * 64 + fr + ai * 128 + m * 16]; float sq = 0.f;
                bf16* rowp = O + (size_t)r * PW + u.pn * 256 + ct;
#pragma unroll
                for (int bj = 0; bj < 2; ++bj) {
                    f32x4 v0 = acc[ai][bj][m][0] * rs, v1 = acc[ai][bj][m][1] * rs;
                    if (rope_b || (rope_a && bj == 0)) {
                        const int c = ct + bj * 128;
                        const f32x2* tp = rope_b ? (cs128 + (size_t)pos * 64 + ((c & 127) >> 1)) : (cs64 + (size_t)pos * 32 + (c >> 1));
                        const f32x4 t0 = *(const f32x4*)tp, t1 = *(const f32x4*)(tp + 2);
                        f32x4 w0, w1;
                        w0[0] = v0[0] * t0[0] - v0[1] * t0[1]; w0[1] = v0[0] * t0[1] + v0[1] * t0[0];
                        w0[2] = v0[2] * t0[2] - v0[3] * t0[3]; w0[3] = v0[2] * t0[3] + v0[3] * t0[2];
                        w1[0] = v1[0] * t1[0] - v1[1] * t1[1]; w1[1] = v1[0] * t1[1] + v1[1] * t1[0];
                        w1[2] = v1[2] * t1[2] - v1[3] * t1[3]; w1[3] = v1[2] * t1[3] + v1[3] * t1[2];
                        v0 = w0; v1 = w1;
                    }
                    v4u w; w.x = pg8::cvt_pk_bf16(v0[0], v0[1]); w.y = pg8::cvt_pk_bf16(v0[2], v0[3]); w.z = pg8::cvt_pk_bf16(v1[0], v1[1]); w.w = pg8::cvt_pk_bf16(v1[2], v1[3]);
                    if (u.pn < 4) st16_wt(rowp + bj * 128, w); else *(v4u*)(rowp + bj * 128) = w;
                    if (u.pn < 4) sq += (v0[0] * v0[0] + v0[1] * v0[1]) + (v0[2] * v0[2] + v0[3] * v0[3]) + (v1[0] * v1[0] + v1[1] * v1[1]) + (v1[2] * v1[2] + v1[3] * v1[3]);
                    if (u.pn == 4 && bj == 0 && ct == 64) *(f32x4*)(fc + (size_t)r * 4) = v0;
                }
                if (u.pn < 4) { sq += __shfl_xor(sq, 16); sq += __shfl_xor(sq, 32); if (fq == 0) ss_add((u.pn < 2 ? ssq : sskv) + r, sq); }
            }
        if (u.pn < 4) { asm volatile("s_waitcnt vmcnt(0)" ::: "memory");
            if (fr == 0 && fq == 0) __hip_atomic_fetch_add(latc + u.pm * 2 + (u.pn >> 1), 1u, __ATOMIC_RELAXED, __HIP_MEMORY_SCOPE_AGENT); }
    }
};
struct EpiUp {
    static constexpr bool PERM = true, ROWS = true; static constexpr float RS_INV = 1.0f / 512.0f, RS_MUL = 1.0f;
    __device__ __forceinline__ const u64* row_ss(const pg8::Unit& u) const { return u.pn < 3 ? ssq : sskv; }
    bf16* O; const u64* ssq; const u64* sskv; const f32x2* cs64;
    __device__ __forceinline__ void operator()(const pg8::f32x4 (&acc)[2][2][4][2], const pg8::Unit& u, int wr, int wc, int fr, int fq, const PG8_LAS float* rt) const {
        const int row0 = u.pm * 256 + wr * 64 + fr, ct = wc * 32 + 8 * fq;
        const bool isq = u.pn < 3;
#pragma unroll
        for (int ai = 0; ai < 2; ++ai)
#pragma unroll
            for (int m = 0; m < 4; ++m) {
                const int r = row0 + ai * 128 + m * 16; const int pos = r & (SEQ - 1); const float rs = rt[wr * 64 + fr + ai * 128 + m * 16];
                bf16* rowp = O + (size_t)r * UPW + u.pn * 256 + ct;
#pragma unroll
                for (int bj = 0; bj < 2; ++bj) {
                    f32x4 v0 = acc[ai][bj][m][0] * rs, v1 = acc[ai][bj][m][1] * rs;
                    const int c = u.pn * 256 + ct + bj * 128;
                    const int e = c % 192;
                    if (isq && e >= 128) {
                        const f32x2* tp = cs64 + (size_t)pos * 32 + ((e - 128) >> 1);
                        const f32x4 t0 = *(const f32x4*)tp, t1 = *(const f32x4*)(tp + 2);
                        f32x4 w0, w1;
                        w0[0] = v0[0] * t0[0] - v0[1] * t0[1]; w0[1] = v0[0] * t0[1] + v0[1] * t0[0];
                        w0[2] = v0[2] * t0[2] - v0[3] * t0[3]; w0[3] = v0[2] * t0[3] + v0[3] * t0[2];
                        w1[0] = v1[0] * t1[0] - v1[1] * t1[1]; w1[1] = v1[0] * t1[1] + v1[1] * t1[0];
                        w1[2] = v1[2] * t1[2] - v1[3] * t1[3]; w1[3] = v1[2] * t1[3] + v1[3] * t1[2];
                        v0 = w0; v1 = w1;
                    }
                    v4u w; w.x = pg8::cvt_pk_bf16(v0[0], v0[1]); w.y = pg8::cvt_pk_bf16(v0[2], v0[3]); w.z = pg8::cvt_pk_bf16(v1[0], v1[1]); w.w = pg8::cvt_pk_bf16(v1[2], v1[3]);
                    *(v4u*)(rowp + bj * 128) = w;
                }
            }
    }
};
struct EpiResid {
    static constexpr bool PERM = true, ROWS = false;
    bf16* xb; unsigned char* xl; u64* ss;
    __device__ __forceinline__ void operator()(const pg8::f32x4 (&acc)[2][2][4][2], const pg8::Unit& u, int wr, int wc, int fr, int fq) const {
        const int row0 = u.pm * 256 + wr * 64 + fr, col0 = u.pn * 256 + wc * 32 + 8 * fq, xoff = u.pn * 256 + wc * 64 + fq * 16;
#pragma unroll
        for (int ai = 0; ai < 2; ++ai) {
            v4u b[4][2]; v4u e[4];
#pragma unroll
            for (int m = 0; m < 4; ++m)
#pragma unroll
                for (int bj = 0; bj < 2; ++bj) { const size_t off = (size_t)(row0 + ai * 128 + m * 16) * DM + col0 + bj * 128; b[m][bj] = *(const v4u*)(xb + off);
                    if (bj == 0) e[m] = *(const v4u*)(xl + (size_t)(row0 + ai * 128 + m * 16) * DM + xoff); }
            float sqmine = 0.f;
#pragma unroll
            for (int m = 0; m < 4; ++m) { const int r = row0 + ai * 128 + m * 16; const size_t off = (size_t)r * DM + col0; float sq = 0.f; unsigned lw[2][2];
#pragma unroll
                for (int bj = 0; bj < 2; ++bj) {
                    const unsigned qh[4] = {b[m][bj].x, b[m][bj].y, b[m][bj].z, b[m][bj].w}; const unsigned ql[2] = {bj ? e[m].z : e[m].x, bj ? e[m].w : e[m].y};
                    float v[8];
                    v[0] = res_join<0>(qh[0], ql[0]); v[1] = res_join<1>(qh[0], ql[0]); v[2] = res_join<2>(qh[1], ql[0]); v[3] = res_join<3>(qh[1], ql[0]);
                    v[4] = res_join<0>(qh[2], ql[1]); v[5] = res_join<1>(qh[2], ql[1]); v[6] = res_join<2>(qh[3], ql[1]); v[7] = res_join<3>(qh[3], ql[1]);
#pragma unroll
                    for (int j = 0; j < 4; ++j) { v[j] += acc[ai][bj][m][0][j]; v[4 + j] += acc[ai][bj][m][1][j]; }
                    unsigned w0_, w1_, w2_, w3_; res_split4(v[0], v[1], v[2], v[3], w0_, w1_, lw[bj][0]); res_split4(v[4], v[5], v[6], v[7], w2_, w3_, lw[bj][1]);
                    *(v4u*)(xb + off + bj * 128) = (v4u){w0_, w1_, w2_, w3_};
#pragma unroll
                    for (int j = 0; j < 8; ++j) sq += v[j] * v[j];
                }
                *(v4u*)(xl + (size_t)r * DM + xoff) = (v4u){lw[0][0], lw[0][1], lw[1][0], lw[1][1]};
                sq += __shfl_xor(sq, 16); sq += __shfl_xor(sq, 32); sqmine = (fq == m) ? sq : sqmine; }
            ss_add(ss + row0 + ai * 128 + fq * 16, sqmine);
            asm volatile("" ::: "memory");
        }
    }
};
struct EpiSwiglu {
    static constexpr bool PERM = true, ROWS = true; static constexpr float RS_INV = 1.0f / 2048.0f, RS_MUL = RES_TRUNC_GAIN;
    __device__ __forceinline__ const u64* row_ss(const pg8::Unit&) const { return ss; }
    bf16* O; const u64* ss;
    __device__ __forceinline__ void operator()(const pg8::f32x4 (&acc)[2][2][4][2], const pg8::Unit& u, int wr, int wc, int fr, int fq, const PG8_LAS float* rt) const {
        const int row0 = u.pm * 256 + wr * 64 + fr, col0 = u.pn * 128 + wc * 32 + 8 * fq;
#pragma unroll
        for (int ai = 0; ai < 2; ++ai)
#pragma unroll
            for (int m = 0; m < 4; ++m) {
                const int r = row0 + ai * 128 + m * 16; const float rs = rt[wr * 64 + fr + ai * 128 + m * 16];
                float h[8];
#pragma unroll
                for (int n = 0; n < 2; ++n)
#pragma unroll
                    for (int j = 0; j < 4; ++j) { const float gt = acc[ai][0][m][n][j] * rs, up = acc[ai][1][m][n][j] * rs;
                        const float sg = __builtin_amdgcn_rcpf(1.0f + __builtin_amdgcn_exp2f(-1.4426950408889634f * gt)); h[n * 4 + j] = gt * sg * up; }
                v4u w; w.x = pg8::cvt_pk_bf16(h[0], h[1]); w.y = pg8::cvt_pk_bf16(h[2], h[3]); w.z = pg8::cvt_pk_bf16(h[4], h[5]); w.w = pg8::cvt_pk_bf16(h[6], h[7]);
                *(v4u*)(O + (size_t)r * FFN + col0) = w;
            }
    }
};

namespace att {
typedef short s16x4 __attribute__((ext_vector_type(4)));
typedef float f32x16 __attribute__((ext_vector_type(16)));
constexpr int SHM_V = 16384, SHM_K = 16384, K2ROW = 144, SHM_K2 = 64 * K2ROW;
constexpr int OFF_V = 0, OFF_K = 2 * SHM_V, OFF_WS = OFF_K + 2 * SHM_K, OFF_FLG = OFF_WS + 8 * 256, OFF_K2 = OFF_FLG + 64, OFF_KB = OFF_K2, OFF_Q2 = OFF_K2 + 2 * SHM_K2, ATT_LDS = OFF_K2 + 8 * 8192;
static_assert(OFF_Q2 + 8 * 4096 <= ATT_LDS && OFF_KB + 16384 <= ATT_LDS && ATT_LDS <= LDSCTL_OFF && (OFF_K2 % 16) == 0, "attention LDS");
#define KSWZ(row, colB) ((row) * 256 + ((colB) ^ (((row) & 7) << 4)))
#define SBAR() __builtin_amdgcn_sched_barrier(0)
__device__ __forceinline__ int v_st(int k, int c) { const int kk = (k & ~0xC) | ((k & 4) << 1) | ((k & 8) >> 1); return ((kk >> 3) * 4 + (c >> 5)) * 512 + ((kk & 7) * 32 + (c & 31)) * 2; }
__device__ __forceinline__ int v_rd_base(int lane) { return ((lane & 3) << 3) | (((lane >> 2) & 3) << 6) | (((lane >> 4) & 1) << 5) | (((lane >> 5) & 1) << 8); }
constexpr int v_rd_off(int d0, int ks, int half) { return d0 * 512 + ks * 4096 + half * 2048; }
__device__ __forceinline__ int crow(int r, int hi) { return (r & 3) + 8 * (r >> 2) + 4 * hi; }
__device__ __forceinline__ unsigned cvtpk(float lo, float hi) { unsigned r; asm volatile("v_cvt_pk_bf16_f32 %0, %1, %2" : "=v"(r) : "v"(lo), "v"(hi)); return r; }

template <int KB, bool MLA, int NQR>
__device__ __forceinline__ void qkt(f32x16& p0, f32x16& p1, const char* lds, int r32, int hi, const bf16x8* qr, const char* q2p) {
    p0 = f32x16{}; p1 = f32x16{};
    const char* kb[4];
#pragma unroll
    for (int dd = 0; dd < 4; ++dd) kb[dd] = lds + OFF_K + KB * SHM_K + KSWZ(r32, (dd * 16 + hi * 8) * 2);
#pragma unroll
    for (int d0 = 0; d0 < 8; ++d0) { const char* a = kb[d0 & 3] + (d0 >> 2) * 128;
        const bf16x8 b0 = *reinterpret_cast<const bf16x8*>(a);
        const bf16x8 b1 = *reinterpret_cast<const bf16x8*>(a + 32 * 256);
        bf16x8 q; if (d0 < NQR) q = qr[d0 < NQR ? d0 : 0]; else q = *reinterpret_cast<const bf16x8*>(q2p + (d0 - NQR) * 1024);
        p0 = __builtin_amdgcn_mfma_f32_32x32x16_bf16(b0, q, p0, 0, 0, 0);
        p1 = __builtin_amdgcn_mfma_f32_32x32x16_bf16(b1, q, p1, 0, 0, 0); }
    if constexpr (MLA) {
        const char* k2 = lds + OFF_K2 + KB * SHM_K2 + r32 * K2ROW + hi * 16;
#pragma unroll
        for (int dd = 0; dd < 4; ++dd) {
            const bf16x8 b0 = *reinterpret_cast<const bf16x8*>(k2 + dd * 32);
            const bf16x8 b1 = *reinterpret_cast<const bf16x8*>(k2 + 32 * K2ROW + dd * 32);
            const bf16x8 q2 = *reinterpret_cast<const bf16x8*>(q2p + (8 - NQR + dd) * 1024);
            p0 = __builtin_amdgcn_mfma_f32_32x32x16_bf16(b0, q2, p0, 0, 0, 0);
            p1 = __builtin_amdgcn_mfma_f32_32x32x16_bf16(b1, q2, p1, 0, 0, 0); }
    }
}
template <int VB>
__device__ __forceinline__ void pv_tile(f32x16* o, int vb0, bf16x8 pa0, bf16x8 pa1, bf16x8 pa2, bf16x8 pa3) {
#define TRRD(dst, off) asm volatile("ds_read_b64_tr_b16 %0, %1 offset:%2" : "=&v"(dst) : "v"(vb0), "i"(off) : "memory")
#define PV_D0(d0) do { s16x4 l0, l1, l2, l3, h0, h1, h2, h3; constexpr int b_ = OFF_V + VB * SHM_V + v_rd_off(d0, 0, 0); \
        TRRD(l0, b_); TRRD(h0, b_ + 2048); TRRD(l1, b_ + 4096); TRRD(h1, b_ + 6144); TRRD(l2, b_ + 8192); TRRD(h2, b_ + 10240); TRRD(l3, b_ + 12288); TRRD(h3, b_ + 14336); \
        asm volatile("s_waitcnt lgkmcnt(0)" ::: "memory"); SBAR(); \
        o[d0] = __builtin_amdgcn_mfma_f32_32x32x16_bf16(pa0, (bf16x8){l0[0], l0[1], l0[2], l0[3], h0[0], h0[1], h0[2], h0[3]}, o[d0], 0, 0, 0); \
        o[d0] = __builtin_amdgcn_mfma_f32_32x32x16_bf16(pa1, (bf16x8){l1[0], l1[1], l1[2], l1[3], h1[0], h1[1], h1[2], h1[3]}, o[d0], 0, 0, 0); \
        o[d0] = __builtin_amdgcn_mfma_f32_32x32x16_bf16(pa2, (bf16x8){l2[0], l2[1], l2[2], l2[3], h2[0], h2[1], h2[2], h2[3]}, o[d0], 0, 0, 0); \
        o[d0] = __builtin_amdgcn_mfma_f32_32x32x16_bf16(pa3, (bf16x8){l3[0], l3[1], l3[2], l3[3], h3[0], h3[1], h3[2], h3[3]}, o[d0], 0, 0, 0); } while (0)
    PV_D0(0); PV_D0(1); PV_D0(2); PV_D0(3);
#undef PV_D0
#undef TRRD
}
__device__ __forceinline__ void pack_p(const f32x16& p0, const f32x16& p1, bf16x8& pa0, bf16x8& pa1, bf16x8& pa2, bf16x8& pa3) {
#define PK4(P, B_, OUT) do { unsigned a0 = cvtpk(P[B_+0], P[B_+1]), a1 = cvtpk(P[B_+2], P[B_+3]); \
        unsigned b0 = cvtpk(P[B_+4], P[B_+5]), b1 = cvtpk(P[B_+6], P[B_+7]); \
        auto r0 = __builtin_amdgcn_permlane32_swap(a0, b0, false, false); auto r1 = __builtin_amdgcn_permlane32_swap(a1, b1, false, false); \
        v4u w = {r0[0], r1[0], r0[1], r1[1]}; OUT = *reinterpret_cast<bf16x8*>(&w); } while (0)
    PK4(p0, 0, pa0); PK4(p0, 8, pa1); PK4(p1, 0, pa2); PK4(p1, 8, pa3);
#undef PK4
}
template <int MODE>
__device__ __forceinline__ void partialSM(f32x16& p0, f32x16& p1, float& m_reg, float& alpha) {
    constexpr float SCALE = (MODE == 0) ? 0.07216878364870323f : 0.08838834764831845f;
    constexpr float C2 = 1.4426950408889634f * SCALE; constexpr float THR = 8.f;
    float pmax = p0[0];
#pragma unroll
    for (int r = 1; r < 16; ++r) pmax = fmaxf(pmax, p0[r]);
#pragma unroll
    for (int r = 0; r < 16; ++r) pmax = fmaxf(pmax, p1[r]);
    { auto rr = __builtin_amdgcn_permlane32_swap(__float_as_uint(pmax), __float_as_uint(pmax), false, false);
      pmax = fmaxf(__uint_as_float(rr[0]), __uint_as_float(rr[1])); }
    float mn;
    if (__builtin_expect(__all((pmax - m_reg) * SCALE <= THR), 1)) { mn = m_reg; alpha = 1.f; }
    else { mn = fmaxf(m_reg, pmax); alpha = __builtin_amdgcn_exp2f((m_reg - mn) * C2); m_reg = mn; }
    const float mnL = -mn * C2;
#pragma unroll
    for (int r = 0; r < 16; ++r) p0[r] = fmaf(p0[r], C2, mnL);
#pragma unroll
    for (int r = 0; r < 16; ++r) p1[r] = fmaf(p1[r], C2, mnL);
#pragma unroll
    for (int r = 0; r < 16; ++r) p0[r] = __builtin_amdgcn_exp2f(p0[r]);
}
__device__ __forceinline__ void finishSM(f32x16& p0, f32x16& p1, float alpha, float& l_reg, bf16x8& pa0, bf16x8& pa1, bf16x8& pa2, bf16x8& pa3) {
#pragma unroll
    for (int r = 0; r < 16; ++r) p1[r] = __builtin_amdgcn_exp2f(p1[r]);
    float ps = 0.f;
#pragma unroll
    for (int r = 0; r < 16; ++r) ps += p0[r];
#pragma unroll
    for (int r = 0; r < 16; ++r) ps += p1[r];
    { auto rr = __builtin_amdgcn_permlane32_swap(__float_as_uint(ps), __float_as_uint(ps), false, false);
      ps = __uint_as_float(rr[0]) + __uint_as_float(rr[1]); }
    l_reg = l_reg * alpha + ps;
    pack_p(p0, p1, pa0, pa1, pa2, pa3);
}
__device__ __forceinline__ float dil_apply(float s, int d) {
    constexpr float INV_SCALE = 11.313708498984761f;
    const unsigned u = (unsigned)d;
    const int cnt = (u <= 128u ? 1 : 0) + (((u & 3u) == 0u && u <= 512u) ? 1 : 0) + (((u & 15u) == 0u && u <= 512u) ? 1 : 0);
    const float b = cnt == 3 ? 1.0986122886681098f * INV_SCALE : (cnt == 2 ? 0.6931471805599453f * INV_SCALE : 0.f);
    return cnt == 0 ? -__builtin_inff() : s + b;
}
__device__ __forceinline__ void sb_tile(f32x16& p0, f32x16& p1, int dq, int hi, float& R) {
    constexpr float C2 = 1.4426950408889634f * 0.08838834764831845f;
    float lk[32];
#pragma unroll
    for (int e = 0; e < 32; ++e) {
        const int r = e & 15; const int c = (r & 3) + 8 * (r >> 2) + (e >= 16 ? 32 : 0);
        const bool valid = (dq - c) >= 1;
        const float z2 = (e < 16 ? p0[r] : p1[r]) * C2;
        const float ex = __builtin_amdgcn_exp2f(-fabsf(z2));
        const float sp = fmaxf(z2, 0.f) + __builtin_amdgcn_logf(1.0f + ex);
        lk[e] = valid ? -sp : 0.f;
        const float ls = valid ? (z2 - sp) : -__builtin_inff();
        if (e < 16) p0[r] = ls; else p1[r] = ls;
    }
    float gs[8];
#pragma unroll
    for (int g = 0; g < 8; ++g) { const float s3 = lk[4 * g + 3], s2 = s3 + lk[4 * g + 2], s1 = s2 + lk[4 * g + 1]; gs[g] = s1 + lk[4 * g];
        lk[4 * g + 3] = 0.f; lk[4 * g + 2] = s3; lk[4 * g + 1] = s2; lk[4 * g] = s1; }
    float run = R;
#pragma unroll
    for (int g = 7; g >= 0; --g) {
        auto rr = __builtin_amdgcn_permlane32_swap(__float_as_uint(gs[g]), __float_as_uint(gs[g]), false, false);
        const float lo = __uint_as_float(rr[0]), hv = __uint_as_float(rr[1]);
        const float base = run + (hi == 0 ? hv : 0.f);
#pragma unroll
        for (int j = 0; j < 4; ++j) lk[4 * g + j] += base;
        run += lo + hv;
    }
    R = run;
#pragma unroll
    for (int r = 0; r < 16; ++r) { p0[r] = __builtin_amdgcn_exp2f(p0[r] + lk[r]); p1[r] = __builtin_amdgcn_exp2f(p1[r] + lk[16 + r]); }
}

struct Blk { const bf16* Q; const bf16* K; const bf16* V; const bf16* K2; const float* kbias; bf16* O; float* lse; int qs, ks, vs, k2s, os, P0, lses; float kmax; };

__device__ __forceinline__ bf16x8 ld8(const bf16* p) { return *reinterpret_cast<const bf16x8*>(p); }

template <int MODE, int ORD>
__device__ __forceinline__ void attn_block(const Blk& c, char* lds) {
    constexpr bool MLA = (MODE == 0), DIL = (MODE == 1), FOX = (MODE == 2), STK = (MODE == 3), DILF = (MODE == 4);
    constexpr int NQ = DIL ? 0 : 8, NQT = MLA ? 12 : 8, Q2OFF = DIL ? OFF_K2 : OFF_Q2, Q2SL = DIL ? 8192 : 4096;
#define BAR_LDS() asm volatile("s_waitcnt lgkmcnt(0)\n\ts_barrier" ::: "memory")
    int tid = threadIdx.x; asm volatile("" : "+v"(tid));
    const int wid = __builtin_amdgcn_readfirstlane(tid >> 6), lane = tid & 63, r32 = lane & 31, hi = lane >> 5;
    const char* q2p = lds + Q2OFF + wid * Q2SL + lane * 16;
    const int j_hi = c.P0 / 64 + 4;
    int j_lo = 0; if (DIL) { j_lo = (c.P0 - 512) / 64; if (j_lo < 0) j_lo = 0; }
    const int NT = j_hi - j_lo;
    const int qlo = c.P0 + wid * 32, qm = qlo + r32 - 4 * hi;
    float* ws = (float*)(lds + OFF_WS) + wid * 64; float* li_l = ws, * al_l = ws + 32;
    const int sr = tid >> 4, sc = (tid & 15) * 8, vst0 = v_st(sr, sc), vst1 = v_st(32 + sr, sc), kws = KSWZ(sr, sc * 2);
    const int k2r = tid >> 3, k2c = (tid & 7) * 8;
    const int vb0 = (int)(uintptr_t)lds + v_rd_base(lane);
#define KBASE(t) ((STK || FOX) ? (j_hi - 1 - (t)) * 64 : (j_lo + (t)) * 64)
    bf16x8 qr[NQ > 0 ? NQ : 1];
#pragma unroll
    for (int d0 = 0; d0 < NQ; ++d0) qr[d0] = ld8(c.Q + (size_t)(wid * 32 + r32) * c.qs + d0 * 16 + hi * 8);
#pragma unroll
    for (int dd = NQ; dd < NQT; ++dd) *(bf16x8*)(lds + Q2OFF + wid * Q2SL + lane * 16 + (dd - NQ) * 1024) = ld8(c.Q + (size_t)(wid * 32 + r32) * c.qs + dd * 16 + hi * 8);
    constexpr bool DS = false;
    struct StSet { bf16x8 k0, k1, v0, v1, k2; };
    StSet stA, stB;
#define SLOAD_S(S, k0_) do { S.v0 = ld8(c.V + (size_t)((k0_) + sr) * c.vs + sc); S.v1 = ld8(c.V + (size_t)((k0_) + 32 + sr) * c.vs + sc); \
                       S.k0 = ld8(c.K + (size_t)((k0_) + sr) * c.ks + sc); S.k1 = ld8(c.K + (size_t)((k0_) + 32 + sr) * c.ks + sc); \
                       if constexpr (MLA) S.k2 = ld8(c.K2 + (size_t)((k0_) + k2r) * c.k2s + k2c); } while (0)
#define SWRITE_S(S, bf) do { *(bf16x8*)(lds + OFF_V + (bf) * SHM_V + vst0) = S.v0; *(bf16x8*)(lds + OFF_V + (bf) * SHM_V + vst1) = S.v1; \
                        *(bf16x8*)(lds + OFF_K + (bf) * SHM_K + kws) = S.k0; *(bf16x8*)(lds + OFF_K + (bf) * SHM_K + kws + 32 * 256) = S.k1; \
                        if constexpr (MLA) *(bf16x8*)(lds + OFF_K2 + (bf) * SHM_K2 + k2r * K2ROW + k2c * 2) = S.k2; } while (0)
#define SLOAD(k0_) SLOAD_S(stA, k0_)
#define SWRITE(bf) SWRITE_S(stA, bf)
    if constexpr (FOX) {
        const int nk = c.P0 + 256;
#pragma unroll
        for (int j = 0; j < 2; ++j) { const int i = tid * 4 + j * 2048;
            if (i < nk) { f32x4 kb_; kb_[0] = __hip_atomic_load(c.kbias + i, __ATOMIC_RELAXED, __HIP_MEMORY_SCOPE_AGENT); kb_[1] = __hip_atomic_load(c.kbias + i + 1, __ATOMIC_RELAXED, __HIP_MEMORY_SCOPE_AGENT);
                          kb_[2] = __hip_atomic_load(c.kbias + i + 2, __ATOMIC_RELAXED, __HIP_MEMORY_SCOPE_AGENT); kb_[3] = __hip_atomic_load(c.kbias + i + 3, __ATOMIC_RELAXED, __HIP_MEMORY_SCOPE_AGENT);
                          *(f32x4*)(lds + OFF_KB + i * 4) = kb_; } }
    }
    if constexpr (FOX) {
        float q2 = 0.f;
#pragma unroll
        for (int d0 = 0; d0 < 8; ++d0)
#pragma unroll
            for (int j = 0; j < 8; ++j) { const float x = __builtin_bit_cast(float, (unsigned)(unsigned short)qr[d0][j] << 16); q2 += x * x; }
        { auto rr = __builtin_amdgcn_permlane32_swap(__float_as_uint(q2), __float_as_uint(q2), false, false); q2 = __uint_as_float(rr[0]) + __uint_as_float(rr[1]); }
#pragma unroll
        for (int o_ = 1; o_ < 32; o_ <<= 1) q2 = fmaxf(q2, __shfl_xor(q2, o_));
        if (lane == 0) ((float*)(lds + OFF_FLG))[8 + wid] = q2;
    }
    SLOAD(KBASE(0)); VM_WAIT(); SWRITE(0);
    BAR_LDS();
    float m_reg = -1e30f, l_reg = 0.f; f32x16 o[4] = {};
    bf16x8 pa0, pa1, pa2, pa3;
#define ADJUST(P0_, P1_, t) do { const int kb_ = KBASE(t); const int dq = qm - kb_; \
        if constexpr (FOX) { const char* bp = lds + OFF_KB + (kb_ + 4 * hi) * 4; \
            _Pragma("unroll") for (int g_ = 0; g_ < 4; ++g_) { const f32x4 b0_ = *(const f32x4*)(bp + 32 * g_), b1_ = *(const f32x4*)(bp + 128 + 32 * g_); \
                _Pragma("unroll") for (int j_ = 0; j_ < 4; ++j_) { P0_[4 * g_ + j_] += b0_[j_]; P1_[4 * g_ + j_] += b1_[j_]; } } } \
        if constexpr (DIL) { const int dlo_ = qlo - kb_ - 63, dhi_ = qlo + 31 - kb_;            \
            const float NEG_ = -__builtin_inff(); \
            if (dlo_ > 512) {                                                                     \
                _Pragma("unroll") for (int r_ = 0; r_ < 16; ++r_) { P0_[r_] = NEG_; P1_[r_] = NEG_; } } \
            else if (dlo_ > 128 && dhi_ <= 512) {                                                 \
                _Pragma("unroll") for (int r_ = 0; r_ < 16; ++r_) { const int c_ = (r_ & 3) + 8 * (r_ >> 2); const int d_ = dq - c_; const bool o4_ = (d_ & 3) == 0, o16_ = (d_ & 15) == 0; \
                    const float b_ = o16_ ? 0.6931471805599453f * 11.313708498984761f : 0.f; P0_[r_] = o4_ ? P0_[r_] + b_ : NEG_; P1_[r_] = o4_ ? P1_[r_] + b_ : NEG_; } } \
            else { \
                _Pragma("unroll") for (int r_ = 0; r_ < 16; ++r_) { const int c_ = (r_ & 3) + 8 * (r_ >> 2); P0_[r_] = dil_apply(P0_[r_], dq - c_); P1_[r_] = dil_apply(P1_[r_], dq - c_ - 32); } } } \
        if constexpr (DILF) { const float NEG_ = -__builtin_inff();                                 \
            _Pragma("unroll") for (int r_ = 0; r_ < 16; ++r_) { const int c_ = (r_ & 3) + 8 * (r_ >> 2); \
                if ((unsigned)(dq - c_ - 33) > 95u) P0_[r_] = NEG_; if ((unsigned)(dq - c_ - 32 - 33) > 95u) P1_[r_] = NEG_; } } \
        if constexpr (MLA || FOX) { if (kb_ + 63 > qlo) { const float NEG_ = -__builtin_inff(); \
            _Pragma("unroll") for (int r_ = 0; r_ < 16; ++r_) { const int c_ = (r_ & 3) + 8 * (r_ >> 2); if (dq - c_ < 0) P0_[r_] = NEG_; if (dq - c_ - 32 < 0) P1_[r_] = NEG_; } } } } while (0)
#define RESC(a) do { if (__any((a) < 1.f)) { if (hi == 0) al_l[r32] = (a); asm volatile("s_waitcnt lgkmcnt(0)" ::: "memory"); \
                     _Pragma("unroll") for (int d_ = 0; d_ < 4; ++d_) _Pragma("unroll") for (int r_ = 0; r_ < 16; ++r_) o[d_][r_] *= al_l[crow(r_, hi)]; } } while (0)
    if constexpr (STK || FOX || DILF) {
        float R = 0.f; f32x16 p0, p1; float uqk = 0.f;
        if constexpr (FOX) { const float* qf = (const float*)(lds + OFF_FLG) + 8; float q2 = qf[0];
#pragma unroll
            for (int w_ = 1; w_ < 8; ++w_) q2 = fmaxf(q2, qf[w_]);
            uqk = sqrtf(q2) * c.kmax * 1.0001f + 1e-3f; }
#define STEP(BUF, t) do { \
        const bool has_next_ = (t) + 1 < NT; \
        if (has_next_) SLOAD(KBASE((t) + 1)); \
          \
        const int kbt_ = KBASE(t); \
        const bool act_ = STK ? (kbt_ < qlo + 31) : (FOX ? (kbt_ <= qlo + 31) : (qlo + 31 - kbt_ >= 33 && qlo - kbt_ - 63 <= 128)); \
        if (act_) { \
            SBAR(); qkt<BUF, MLA, NQ>(p0, p1, lds, r32, hi, qr, q2p); \
            if constexpr (STK) { sb_tile(p0, p1, qm - kbt_, hi, R); pack_p(p0, p1, pa0, pa1, pa2, pa3); } \
            else { ADJUST(p0, p1, (t)); float al_; partialSM<MODE>(p0, p1, m_reg, al_); RESC(al_); finishSM(p0, p1, al_, l_reg, pa0, pa1, pa2, pa3); } \
            SBAR(); pv_tile<BUF>(o, vb0, pa0, pa1, pa2, pa3); } \
        int dn_ = 0; \
        if constexpr (STK) dn_ = __all(R < -135.f) ? 1 : 0; \
        if constexpr (FOX) { const float kbn_ = has_next_ ? *(const float*)(lds + OFF_KB + (kbt_ - 1) * 4) : 0.f; \
               dn_ = __all((uqk + kbn_ - m_reg) * 0.08838834764831845f < -94.f) ? 1 : 0; } \
        if (has_next_) { VM_WAIT(); SWRITE((BUF) ^ 1); } \
        if (lane == 0) flg[wid] = dn_; \
        BAR_LDS(); } while (0)
#define SB_DONE() ((flg[0] & flg[1] & flg[2] & flg[3] & flg[4] & flg[5] & flg[6] & flg[7]) != 0)
        volatile LAS int* flg = (volatile LAS int*)(lds + OFF_FLG);
        for (int t = 0; t < NT; t += 2) {
            STEP(0, t);
            if (SB_DONE()) break;
            if (t + 1 < NT) { STEP(1, t + 1); if (SB_DONE()) break; }
        }
        BAR_LDS();
#undef SB_DONE
#undef STEP
    } else {
        f32x16 pA0, pA1, pB0, pB1; float alA, alB;
        if (NT > 1) { if constexpr (DS) SLOAD_S(stB, KBASE(1)); else SLOAD_S(stA, KBASE(1)); }
        SBAR(); qkt<0, MLA, NQ>(pA0, pA1, lds, r32, hi, qr, q2p);
        ADJUST(pA0, pA1, 0); partialSM<MODE>(pA0, pA1, m_reg, alA);
        if (NT > 1) { if constexpr (DS) { SWRITE_S(stB, 1); SBAR(); if (NT > 2) SLOAD_S(stA, KBASE(2)); if (NT > 3) SLOAD_S(stB, KBASE(3)); }
                      else { SWRITE_S(stA, 1); SBAR(); if (NT > 2) SLOAD_S(stA, KBASE(2)); } }
        BAR_LDS();
#define HALF_STEP(ORD, PX0, PX1, alX, PY0, PY1, alY, t, KB, VB, SB) do { \
        if (ORD == 0) { \
            SBAR(); qkt<KB, MLA, NQ>(PX0, PX1, lds, r32, hi, qr, q2p); SBAR(); \
            finishSM(PY0, PY1, alY, l_reg, pa0, pa1, pa2, pa3); SBAR(); \
            pv_tile<VB>(o, vb0, pa0, pa1, pa2, pa3); SBAR(); ADJUST(PX0, PX1, (t)); partialSM<MODE>(PX0, PX1, m_reg, alX); \
        } else { \
            SBAR(); finishSM(PY0, PY1, alY, l_reg, pa0, pa1, pa2, pa3); SBAR(); \
            qkt<KB, MLA, NQ>(PX0, PX1, lds, r32, hi, qr, q2p); SBAR(); \
            ADJUST(PX0, PX1, (t)); partialSM<MODE>(PX0, PX1, m_reg, alX); SBAR(); pv_tile<VB>(o, vb0, pa0, pa1, pa2, pa3); \
        } \
        BAR_LDS(); \
        if ((t) + 1 < NT) { if constexpr (DS) { if ((SB) == 0) { SWRITE_S(stA, 0); SBAR(); if ((t) + 3 < NT) SLOAD_S(stA, KBASE((t) + 3)); } else { SWRITE_S(stB, 1); SBAR(); if ((t) + 3 < NT) SLOAD_S(stB, KBASE((t) + 3)); } } \
                            else { SWRITE_S(stA, SB); SBAR(); if ((t) + 2 < NT) SLOAD_S(stA, KBASE((t) + 2)); } } \
        RESC(alX); BAR_LDS(); } while (0)
        for (int t = 1; t + 1 < NT; t += 2) {
            HALF_STEP(ORD, pB0, pB1, alB, pA0, pA1, alA, t, 1, 0, 0);
            HALF_STEP(ORD, pA0, pA1, alA, pB0, pB1, alB, t + 1, 0, 1, 1);
        }
        const bool even = (NT & 1) == 0;
        if (even) { SBAR(); qkt<1, MLA, NQ>(pB0, pB1, lds, r32, hi, qr, q2p); SBAR(); }
        finishSM(pA0, pA1, alA, l_reg, pa0, pa1, pa2, pa3); SBAR();
        pv_tile<0>(o, vb0, pa0, pa1, pa2, pa3);
        if (even) { ADJUST(pB0, pB1, NT - 1); partialSM<MODE>(pB0, pB1, m_reg, alB); RESC(alB);
            finishSM(pB0, pB1, alB, l_reg, pa0, pa1, pa2, pa3); SBAR(); pv_tile<1>(o, vb0, pa0, pa1, pa2, pa3); }
#undef HALF_STEP
    }
#undef RESC
    constexpr float SCL = (MODE == 0) ? 0.07216878364870323f : 0.08838834764831845f;
    float rli[16], wf[16];
    if constexpr (STK) {
#pragma unroll
        for (int r = 0; r < 16; ++r) { rli[r] = 1.f; wf[r] = 0.f; }
    } else {
        float sc_ = l_reg > 0.f ? __builtin_amdgcn_rcpf(l_reg) : 0.f, wF_ = 0.f;
        if constexpr (DILF) {
            const float lse_ = l_reg > 0.f ? m_reg * SCL + __logf(l_reg) : -__builtin_inff();
            if (hi == 0) __hip_atomic_store(c.lse + (size_t)(wid * 32 + r32) * c.lses, lse_, __ATOMIC_RELAXED, __HIP_MEMORY_SCOPE_AGENT);
        }
        if constexpr (DIL) {
            const float lseF_ = __hip_atomic_load(c.lse + (size_t)(wid * 32 + r32) * c.lses, __ATOMIC_RELAXED, __HIP_MEMORY_SCOPE_AGENT), lseN_ = m_reg * SCL + __logf(l_reg);
            const float wN_ = __builtin_amdgcn_rcpf(1.0f + __expf(lseF_ - lseN_)); wF_ = 1.0f - wN_; sc_ *= wN_;
        }
        if (hi == 0) { li_l[r32] = sc_; al_l[r32] = wF_; } asm volatile("s_waitcnt lgkmcnt(0)" ::: "memory");
#pragma unroll
        for (int r = 0; r < 16; ++r) { rli[r] = li_l[crow(r, hi)]; wf[r] = DIL ? al_l[crow(r, hi)] : 0.f; }
    }
    bf16* Ow = c.O + (size_t)(wid * 32) * c.os;
    if constexpr (!(STK || FOX || DILF)) BAR_LDS();
    char* stg = lds + wid * 8192;
    if constexpr (DIL) {
#pragma unroll
        for (int i = 0; i < 16; ++i) { const int row = 2 * i + (lane >> 5), c8 = lane & 31;
            const unsigned long long q = __hip_atomic_load((const unsigned long long*)(Ow + (size_t)row * c.os + c8 * 4), __ATOMIC_RELAXED, __HIP_MEMORY_SCOPE_AGENT);
            *(unsigned long long*)(stg + row * 256 + c8 * 8) = q; }
        asm volatile("s_waitcnt lgkmcnt(0)" ::: "memory");
#pragma unroll
        for (int r = 0; r < 16; ++r)
#pragma unroll
            for (int d0 = 0; d0 < 4; ++d0) { const unsigned of = *(const unsigned short*)(stg + crow(r, hi) * 256 + (d0 * 32 + r32) * 2);
                o[d0][r] = o[d0][r] * rli[r] + wf[r] * __builtin_bit_cast(float, of << 16); }
#pragma unroll
        for (int r = 0; r < 16; ++r) rli[r] = 1.f;
        asm volatile("s_waitcnt lgkmcnt(0)" ::: "memory");
    }
    { const bool odd = (r32 & 1) != 0;
#pragma unroll
    for (int r = 0; r < 16; ++r) { const int row = crow(r, hi);
#pragma unroll
        for (int dp = 0; dp < 4; dp += 2) {
            const float va = o[dp][r] * rli[r], vb = o[dp + 1][r] * rli[r];
            const float rcv = __int_as_float(__builtin_amdgcn_update_dpp(0, __float_as_int(odd ? va : vb), 0xB1, 0xF, 0xF, true));
            const unsigned pk = cvtpk(odd ? rcv : va, odd ? vb : rcv);
            *(unsigned*)(stg + row * 256 + (odd ? (dp + 1) * 32 + r32 - 1 : dp * 32 + r32) * 2) = pk; } } }
    asm volatile("s_waitcnt lgkmcnt(0)" ::: "memory");
#pragma unroll
    for (int i = 0; i < 8; ++i) { const int row = 4 * i + (lane >> 4); const v4u q = *(const v4u*)(stg + row * 256 + (lane & 15) * 16);
        st16_wt(Ow + (size_t)row * c.os + (lane & 15) * 8, q); }
    BAR_LDS();
#undef ADJUST
#undef BAR_LDS
#undef KBASE
#undef SLOAD
#undef SWRITE
#undef SLOAD_S
#undef SWRITE_S
}
#undef KSWZ
#undef SBAR
}

#define XB_TMO      128
#define XB_XCNT(j)  (256  + 64 * (j))
#define XB_XSUB(j)  (1280 + 64 * (j))
#define XB_XGEN(j)  (2304 + 64 * (j))
#define XB_TOP      3328
#define XB_TOPGEN   3392
#define XCD_BAR_WORDS 3456
#define XB_SPIN_CAP (1u << 18)
__device__ __forceinline__ unsigned xb_ld(unsigned* p)              { return __hip_atomic_load(p, __ATOMIC_RELAXED, __HIP_MEMORY_SCOPE_AGENT); }
__device__ __forceinline__ unsigned xb_add(unsigned* p, unsigned v) { return __hip_atomic_fetch_add(p, v, __ATOMIC_RELAXED, __HIP_MEMORY_SCOPE_AGENT); }
__device__ __forceinline__ unsigned xb_xcc_id() { return (unsigned)__builtin_amdgcn_s_getreg((3 << 11) | 20) & 0xFu; }
#define XB_SPIN(cond, bar) do { unsigned _sp = 0; while (cond) { __builtin_amdgcn_s_sleep(1); \
    if ((++_sp & 255u) == 0u) { if (xb_ld(&(bar)[XB_TMO])) break; if (_sp > XB_SPIN_CAP) { atomicAdd(&(bar)[XB_TMO], 1u); break; } } } } while (0)
struct XcdBarrier { unsigned* bar; unsigned x; volatile LAS unsigned* st; };
__device__ __forceinline__ XcdBarrier xcd_barrier_post(unsigned* bar, volatile LAS unsigned* st) {
    XcdBarrier b; b.bar = bar; b.x = xb_xcc_id(); b.st = st;
    if (threadIdx.x == 0) (void)xb_add(&bar[XB_XCNT(b.x)], 1u);
    return b;
}
__device__ __forceinline__ void xcd_barrier_complete(unsigned* bar, unsigned x, unsigned& nloc, unsigned& nx) {
    const unsigned G = gridDim.x * gridDim.y * gridDim.z;
    unsigned sum, cnt, mine, sp = 0u;
    for (;;) {
        sum = 0u; cnt = 0u; mine = 0u;
#pragma unroll
        for (unsigned j = 0; j < 16; ++j) { const unsigned c = xb_ld(&bar[XB_XCNT(j)]); sum += c; cnt += (c > 0u) ? 1u : 0u; mine = (j == x) ? c : mine; }
        if (sum == G) break;
        __builtin_amdgcn_s_sleep(1);
        if ((++sp & 255u) == 0u) { if (xb_ld(&bar[XB_TMO])) break; if (sp > XB_SPIN_CAP) { atomicAdd(&bar[XB_TMO], 1u); break; } }
    }
    nloc = mine > 0u ? mine : 1u; nx = cnt > 0u ? cnt : 1u;
}
__device__ __forceinline__ void xcd_barrier(const XcdBarrier& b) {
    asm volatile("s_waitcnt vmcnt(0)" ::: "memory");
    __syncthreads();
    if (threadIdx.x == 0) {
        size_t zb_ = 0; asm volatile("" : "+s"(zb_));
        unsigned* bar = b.bar + zb_;
        __builtin_amdgcn_s_waitcnt(0);
        unsigned nloc = b.st[0], nx = b.st[1];
        if (nloc == 0u) { xcd_barrier_complete(bar, b.x, nloc, nx); b.st[0] = nloc; b.st[1] = nx; }
        const unsigned old = xb_add(&bar[XB_XSUB(b.x)], 1u);
        const unsigned gen = old / nloc;
        if (old + 1u == (gen + 1u) * nloc) {
            __builtin_amdgcn_fence(__ATOMIC_RELEASE, "agent");
            asm volatile("s_waitcnt vmcnt(0)" ::: "memory");
            const unsigned og = xb_add(&bar[XB_TOP], 1u);
            const unsigned tg = og / nx;
            if (og + 1u == (tg + 1u) * nx) xb_add(&bar[XB_TOPGEN], 1u);
            else XB_SPIN(xb_ld(&bar[XB_TOPGEN]) == tg, bar);
            __builtin_amdgcn_fence(__ATOMIC_ACQUIRE, "agent");
            xb_add(&bar[XB_XGEN(b.x)], 1u);
            asm volatile("s_waitcnt vmcnt(0)" ::: "memory");
        } else {
            XB_SPIN(xb_ld(&bar[XB_XGEN(b.x)]) == gen, bar);
            __builtin_amdgcn_fence(__ATOMIC_ACQUIRE, "agent");
            asm volatile("s_waitcnt vmcnt(0)" ::: "memory");
        }
    }
    __syncthreads();
}

struct Args {
    const float* in[15]; float* out; unsigned char* ws;
    double invf128[64]; double invf64[32];
    int ph_lo, ph_hi;
};
struct Frame {
    LAS unsigned char* lds; volatile LAS unsigned* MISC; unsigned* ctl;
    int tid, lane, wave, vcu, G;
};
__device__ __forceinline__ float wave_sum(float v) {
#pragma unroll
    for (int o = 1; o < 64; o <<= 1) v += __shfl_xor(v, o);
    return v;
}
__device__ __forceinline__ void sincos_d(double a, float& c, float& s) {
    const double TWO_PI = 6.283185307179586476925286766559, INV_TWO_PI = 0.15915494309189533576888376337251;
    const double k = __builtin_rint(a * INV_TWO_PI); double r = a - k * TWO_PI;
    const double r2 = r * r;
    double sv = 0.0, cv = 0.0;
    double ts = 1.0, tc = 1.0; sv = 1.0; cv = 1.0;
#pragma unroll
    for (int n = 1; n <= 14; ++n) { tc = -tc * r2 * (1.0 / (double)((2 * n - 1) * (2 * n))); ts = -ts * r2 * (1.0 / (double)((2 * n) * (2 * n + 1))); cv += tc; sv += ts; }
    c = (float)cv; s = (float)(sv * r);
}
__device__ __forceinline__ void p_tables(const Frame& F, const Args& a, unsigned char* ws) {
    f32x2* cs128 = (f32x2*)(ws + WS_CS128); f32x2* cs64 = (f32x2*)(ws + WS_CS64);
    const int gt = F.vcu * 512 + F.tid, NT_ = F.G * 512;
    for (int i = gt; i < SEQ * 64; i += NT_) { const int pos = i >> 6, f = i & 63; float c, s; sincos_d((double)(float)((float)pos * (float)a.invf128[f]), c, s); cs128[i] = (f32x2){c, s}; }
    for (int i = gt; i < SEQ * 32; i += NT_) { const int pos = i >> 5, f = i & 31; float c, s; sincos_d((double)(float)((float)pos * (float)a.invf64[f]), c, s); cs64[i] = (f32x2){c, s}; }
}
template <class RMap>
__device__ __forceinline__ void cvt_item(const float* W, int N, bf16* WT, int ldk, const float* gain, const RMap& rmap, LAS float* scr, int item, int lane) {
    const int nblk = (N + 31) / 32, kb = item / nblk, nb = item % nblk, k0 = 64 * kb, n0 = 32 * nb;
    const int nn = n0 + (lane & 31); const bool inb = nn < N;
    const float* src = W + (size_t)(k0 + (lane >> 5)) * N + (inb ? nn : 0);
    float v[32];
#pragma unroll
    for (int i = 0; i < 32; ++i) v[i] = src[(size_t)(2 * i) * N];
    const int c = lane & 7;
    f32x4 g0 = {1.f, 1.f, 1.f, 1.f}, g1 = g0;
    if (gain) { g0 = *(const f32x4*)(gain + k0 + 8 * c); g1 = *(const f32x4*)(gain + k0 + 8 * c + 4); }
#pragma unroll
    for (int i = 0; i < 32; ++i) scr[(2 * i + (lane >> 5)) * 33 + (lane & 31)] = inb ? v[i] : 0.f;
    LDS_WAIT(); asm volatile("" ::: "memory");
#pragma unroll
    for (int j = 0; j < 4; ++j) { const int nl = (lane >> 3) + 8 * j; const LAS float* s = scr + (8 * c) * 33 + nl;
        v4u o; o.x = pk2(s[0 * 33] * g0[0], s[1 * 33] * g0[1]); o.y = pk2(s[2 * 33] * g0[2], s[3 * 33] * g0[3]); o.z = pk2(s[4 * 33] * g1[0], s[5 * 33] * g1[1]); o.w = pk2(s[6 * 33] * g1[2], s[7 * 33] * g1[3]);
        if (n0 + nl < N) *(v4u*)(WT + (size_t)rmap(n0 + nl) * ldk + k0 + 8 * c) = o; }
    LDS_WAIT(); asm volatile("" ::: "memory");
}
struct MapIn { __device__ __forceinline__ int operator()(int n) const {
    if (n < 1024) return n;
    if (n < 1088) { const int i = n - 1024; return PC_KROPE + (i < 32 ? 2 * i : 2 * (i - 32) + 1); }
    if (n < 2112) { const int j = n - 1088, grp = j >> 9, r = j & 511, h = r >> 7, i = r & 127; return PC_QB + grp * 512 + h * 128 + (i < 64 ? 2 * i : 2 * (i - 64) + 1); }
    if (n < 2624) return PC_VB + (n - 2112);
    if (n < 4160) return PC_QC + (n - 2624);
    if (n < 4164) return PC_FC + (n - 4160);
    return PC_QD + (n - 4164); } };
struct MapUq { __device__ __forceinline__ int operator()(int n) const { const int h = n / 192, e = n % 192; if (e < 128) return n; const int j = e - 128; return h * 192 + 128 + (j < 32 ? 2 * j : 2 * (j - 32) + 1); } };
struct MapUkv { __device__ __forceinline__ int operator()(int n) const { const int h = n >> 8, e = n & 255; return 768 + (e < 128 ? h * 128 + e : 512 + h * 128 + (e - 128)); } };
struct MapId { __device__ __forceinline__ int operator()(int n) const { return n; } };
struct MapGate { int up; __device__ __forceinline__ int operator()(int n) const { return 256 * (n >> 7) + (n & 127) + up * 128; } };

__device__ __forceinline__ void p_convert(const Frame& F0, const Args& a, int l, bf16* WB, int max_units = 1 << 30) {
    Frame F = F0; { int t_ = threadIdx.x; asm volatile("" : "+v"(t_)); F.tid = t_; F.lane = t_ & 63; F.wave = __builtin_amdgcn_readfirstlane(t_ >> 6); }
    LAS float* scr = (LAS float*)(F.lds + F.wave * 16384);
    int kz = 0; asm volatile("" : "+s"(kz));
    const float* w_in = a.in[2 + kz] + (size_t)l * DM * IN_W;   const float* g_attn = a.in[1 + kz] + (size_t)l * DM;
    const float* w_uq = a.in[4 + kz] + (size_t)l * 512 * 768;    const float* g_q = a.in[3 + kz] + (size_t)l * 512;
    const float* w_ukv = a.in[6 + kz] + (size_t)l * 512 * 1024;  const float* g_kv = a.in[5 + kz] + (size_t)l * 512;
    const float* w_out = a.in[9 + kz] + (size_t)l * DM * DM;     const float* g_grp = a.in[8 + kz] + (size_t)l * DM;
    const float* w_gate = a.in[11 + kz] + (size_t)l * DM * FFN;  const float* w_up = a.in[12 + kz] + (size_t)l * DM * FFN; const float* g_ffn = a.in[10 + kz] + (size_t)l * DM;
    const float* w_down = a.in[13 + kz] + (size_t)l * FFN * DM;
    constexpr int I_IN = (DM / 64) * ((IN_W + 31) / 32), I_UQ = (512 / 64) * (768 / 32), I_UKV = (512 / 64) * (1024 / 32), I_OUT = (DM / 64) * (DM / 32),
                  I_G = (DM / 64) * (FFN / 32), I_DN = (FFN / 64) * (DM / 32);
    constexpr int NITEMS = I_IN + I_UQ + I_UKV + I_OUT + 2 * I_G + I_DN, NUNITS = (NITEMS + 63) / 64;
    unsigned* head = F.ctl + CW_CVTQ + l * 64;
    for (int done_ = 0; done_ < max_units; ++done_) {
        if (F.tid == 0) F.MISC[17] = __hip_atomic_fetch_add(head, 1u, RLX_AGENT);
        __syncthreads();
        const unsigned unit = (unsigned)__builtin_amdgcn_readfirstlane((int)F.MISC[17]);
        __syncthreads();
        if (unit > (unsigned)NUNITS) break;
        if (unit == (unsigned)NUNITS) {
            v4u* z = (v4u*)(WB + WB_IN + (size_t)PC_PAD0 * DM); const int n16 = (PC_QB - PC_PAD0) * DM / 8;
            unsigned zz = 0u; asm volatile("" : "+v"(zz));
            for (int i = F.tid; i < n16; i += 512) z[i] = (v4u){zz, zz, zz, zz};
            continue;
        }
        for (int j = 0; j < 8; ++j) {
            int r = (int)unit * 64 + F.wave * 8 + j; if (r >= NITEMS) break;
            if (r < I_IN) { cvt_item(w_in, IN_W, WB + WB_IN, DM, g_attn, MapIn{}, scr, r, F.lane); continue; } r -= I_IN;
            if (r < I_UQ) { cvt_item(w_uq, 768, WB + WB_UP, 512, g_q, MapUq{}, scr, r, F.lane); continue; } r -= I_UQ;
            if (r < I_UKV) { cvt_item(w_ukv, 1024, WB + WB_UP, 512, g_kv, MapUkv{}, scr, r, F.lane); continue; } r -= I_UKV;
            if (r < I_OUT) { cvt_item(w_out, DM, WB + WB_OUT, DM, g_grp, MapId{}, scr, r, F.lane); continue; } r -= I_OUT;
            if (r < I_G) { cvt_item(w_gate, FFN, WB + WB_GU, DM, g_ffn, MapGate{0}, scr, r, F.lane); continue; } r -= I_G;
            if (r < I_G) { cvt_item(w_up, FFN, WB + WB_GU, DM, g_ffn, MapGate{1}, scr, r, F.lane); continue; } r -= I_G;
            cvt_item(w_down, DM, WB + WB_DN, FFN, (const float*)nullptr, MapId{}, scr, r, F.lane);
        }
    }
}
__device__ __forceinline__ void p_rownorm(const Frame& F, const float* x, bf16* xb, unsigned char* xl, u64* ss) {
    const int gw = F.vcu * 8 + F.wave, NGW = F.G * 8;
    f32x4 v[8];
    if (gw < M) { const f32x4* xr = (const f32x4*)(x + (size_t)gw * DM) + F.lane;
#pragma unroll
        for (int j = 0; j < 8; ++j) v[j] = xr[64 * j]; }
    for (int m = gw; m < M; m += NGW) {
        const int mn = m + NGW; f32x4 nv[8];
#pragma unroll
        for (int j = 0; j < 8; ++j) nv[j] = v[j];
        if (mn < M) { const f32x4* xn = (const f32x4*)(x + (size_t)mn * DM) + F.lane;
#pragma unroll
            for (int j = 0; j < 8; ++j) nv[j] = xn[64 * j]; }
        float s = 0.f;
#pragma unroll
        for (int j = 0; j < 8; ++j) s += (v[j].x * v[j].x + v[j].y * v[j].y) + (v[j].z * v[j].z + v[j].w * v[j].w);
        s = wave_sum(s);
        if (F.lane == 0) ss[m] = (u64)(s * SS_FIX + 0.5f);
        v2u* o8 = (v2u*)(xb + (size_t)m * DM) + F.lane; unsigned char* o4 = xl + (size_t)m * DM;
#pragma unroll
        for (int j = 0; j < 8; ++j) { unsigned h0, h1, ex; res_split4(v[j].x, v[j].y, v[j].z, v[j].w, h0, h1, ex); o8[64 * j] = (v2u){h0, h1}; *(unsigned*)(o4 + xl_idx((64 * j + F.lane) * 4)) = ex; }
#pragma unroll
        for (int j = 0; j < 8; ++j) v[j] = nv[j];
    }
}
__device__ __forceinline__ void p_final(const Frame& F, const bf16* xb, const unsigned char* xl, float* out, const float* gain) {
    const int gw = F.vcu * 8 + F.wave, NGW = F.G * 8;
    f32x4 g[4][2];
#pragma unroll
    for (int j = 0; j < 4; ++j) { const int c8 = (64 * j + F.lane) * 2; g[j][0] = ((const f32x4*)gain)[c8]; g[j][1] = ((const f32x4*)gain)[c8 + 1]; }
    v4u q[4]; v2u e[4];
    if (gw < M) { const v4u* xr = (const v4u*)(xb + (size_t)gw * DM) + F.lane; const unsigned char* er = xl + (size_t)gw * DM;
#pragma unroll
        for (int j = 0; j < 4; ++j) { q[j] = xr[64 * j]; e[j] = *(const v2u*)(er + xl_idx((64 * j + F.lane) * 8)); } }
    for (int m = gw; m < M; m += NGW) {
        const int mn = m + NGW; v4u nq[4]; v2u ne[4];
#pragma unroll
        for (int j = 0; j < 4; ++j) { nq[j] = q[j]; ne[j] = e[j]; }
        if (mn < M) { const v4u* xr = (const v4u*)(xb + (size_t)mn * DM) + F.lane; const unsigned char* er = xl + (size_t)mn * DM;
#pragma unroll
            for (int j = 0; j < 4; ++j) { nq[j] = xr[64 * j]; ne[j] = *(const v2u*)(er + xl_idx((64 * j + F.lane) * 8)); } }
        float v[4][8]; float s = 0.f;
#pragma unroll
        for (int j = 0; j < 4; ++j) { const unsigned qh[4] = {q[j].x, q[j].y, q[j].z, q[j].w}; const unsigned ql[2] = {e[j].x, e[j].y};
            v[j][0] = res_join<0>(qh[0], ql[0]); v[j][1] = res_join<1>(qh[0], ql[0]); v[j][2] = res_join<2>(qh[1], ql[0]); v[j][3] = res_join<3>(qh[1], ql[0]);
            v[j][4] = res_join<0>(qh[2], ql[1]); v[j][5] = res_join<1>(qh[2], ql[1]); v[j][6] = res_join<2>(qh[3], ql[1]); v[j][7] = res_join<3>(qh[3], ql[1]);
#pragma unroll
            for (int k = 0; k < 8; ++k) s += v[j][k] * v[j][k]; }
        s = wave_sum(s);
        const float rs = 1.0f / sqrtf(s * (1.0f / DM) + EPS);
        f32x4* orow = (f32x4*)(out + (size_t)m * DM);
#pragma unroll
        for (int j = 0; j < 4; ++j) { const int c8 = (64 * j + F.lane) * 2;
            orow[c8] = (f32x4){v[j][0], v[j][1], v[j][2], v[j][3]} * rs * g[j][0];
            orow[c8 + 1] = (f32x4){v[j][4], v[j][5], v[j][6], v[j][7]} * rs * g[j][1]; }
#pragma unroll
        for (int j = 0; j < 4; ++j) { q[j] = nq[j]; e[j] = ne[j]; }
    }
}
__device__ __forceinline__ void p_foxscan(const Frame& F, const Args& a, int l, unsigned char* ws, int bh, int part) {
    const int b = bh >> 2, h = bh & 3; const float fb = a.in[7][l * 4 + h];
    volatile LAS float* wt = (volatile LAS float*)(F.MISC + 32);
    if (part == 0) {
    const float* fc = (const float*)(ws + WS_FC) + (size_t)b * SEQ * 4 + h; float* kb = (float*)(ws + WS_KBIAS) + (size_t)bh * SEQ;
    float v[8]; float tot = 0.f;
#pragma unroll
    for (int i = 0; i < 8; ++i) { const float f = fc[(size_t)(F.tid * 8 + i) * 4] + fb; tot += fminf(f, 0.f) - __logf(1.0f + __expf(-fabsf(f))); v[i] = tot; }
    float inc = tot;
#pragma unroll
    for (int o = 1; o < 64; o <<= 1) { const float t = __shfl_up(inc, o); if (F.lane >= o) inc += t; }
    if (F.lane == 63) wt[F.wave] = inc;
    __syncthreads();
    float off = inc - tot;
    for (int w = 0; w < 8; ++w) if (w < F.wave) off += wt[w];
#pragma unroll
    for (int i = 0; i < 8; ++i) v[i] = -(v[i] + off) * 11.313708498984761f;
    st16_wt(kb + F.tid * 8, __builtin_bit_cast(v4u, (f32x4){v[0], v[1], v[2], v[3]})); st16_wt(kb + F.tid * 8 + 4, __builtin_bit_cast(v4u, (f32x4){v[4], v[5], v[6], v[7]}));
    }
    const bf16* kp = (const bf16*)(ws + WS_PROJ) + (size_t)b * SEQ * PW + PC_KC + h * 128 + (F.lane & 15) * 8;
    float kmx = 0.f;
    for (int i0 = part * (SEQ / 128); i0 < (part + 1) * (SEQ / 128); i0 += 8) {
        v4u wv[8];
#pragma unroll
        for (int k = 0; k < 8; ++k) wv[k] = *(const v4u*)(kp + (size_t)((i0 + k) * 32 + F.wave * 4 + (F.lane >> 4)) * PW);
#pragma unroll
        for (int k = 0; k < 8; ++k) { const v4u w = wv[k];
            float s2 = bflo(w.x) * bflo(w.x) + bfhi(w.x) * bfhi(w.x) + bflo(w.y) * bflo(w.y) + bfhi(w.y) * bfhi(w.y) + bflo(w.z) * bflo(w.z) + bfhi(w.z) * bfhi(w.z) + bflo(w.w) * bflo(w.w) + bfhi(w.w) * bfhi(w.w);
#pragma unroll
            for (int o = 1; o < 16; o <<= 1) s2 += __shfl_xor(s2, o);
            kmx = fmaxf(kmx, s2); } }
#pragma unroll
    for (int o = 16; o < 64; o <<= 1) kmx = fmaxf(kmx, __shfl_xor(kmx, o));
    if (F.lane == 0) wt[8 + F.wave] = kmx;
    VM_WAIT();
    __syncthreads();
    if (F.tid == 0) { float m = wt[8]; for (int w = 1; w < 8; ++w) m = fmaxf(m, wt[8 + w]); __hip_atomic_fetch_max(F.ctl + CW_KMAX + l * 64 + bh, __float_as_uint(m), RLX_AGENT);
                      VM_WAIT(); __hip_atomic_fetch_add(F.ctl + CW_SCN + l * 64 + bh, 1u, RLX_AGENT); }
    __syncthreads();
}
template <int MODE>
__device__ __forceinline__ void p_attn_mode(const Frame& F, unsigned char* ws, int l, char* ldsg, const Args& args) {
    const bf16* proj = (const bf16*)(ws + WS_PROJ); const bf16* mla = (const bf16*)(ws + WS_MLA); bf16* y = (bf16*)(ws + WS_Y);
    unsigned* heads = F.ctl + CW_ATTQ + (l * 5 + MODE) * 8 * 64;
    unsigned qx = xb_xcc_id() & 7u, qtried = 0u;
#define ATT_DEQUEUE() do { unsigned it_ = 0xffffffffu; while (qtried < 8u) { const unsigned i_ = __hip_atomic_fetch_add(heads + qx * 64, 1u, RLX_AGENT); \
            if (i_ < 64u) { it_ = qx * 64u + i_; break; } qx = (qx + 1u) & 7u; ++qtried; } F.MISC[16] = it_; } while (0)
    if (F.tid == 0) ATT_DEQUEUE();
    __syncthreads();
    unsigned item = (unsigned)__builtin_amdgcn_readfirstlane((int)F.MISC[16]);
    __syncthreads();
    while (item < 512u) {
        const int qb_raw = (int)((item & 63u) >> 2), qb = 15 - qb_raw, bh = (int)((item >> 6) * 4u + (item & 3u)), b = bh >> 2, h = bh & 3;
        att::Blk c; c.P0 = qb * 256; c.kbias = nullptr; c.K2 = nullptr; c.k2s = 0; c.lse = nullptr; c.lses = 1;
        const size_t tok0 = (size_t)b * SEQ;
        if (MODE == 1) {
            if (F.tid == 0) { unsigned sp_ = 0; while (__hip_atomic_load(F.ctl + CW_FDN + l * 64 + bh, RLX_AGENT) < 16u) { __builtin_amdgcn_s_sleep(4); if (++sp_ > (1u << 22)) break; } }
            __syncthreads();
        }
        if (MODE == 2) {
            if (F.tid == 0) { unsigned sp_ = 0; while (__hip_atomic_load(F.ctl + CW_SCN + l * 64 + bh, RLX_AGENT) < 4u) { __builtin_amdgcn_s_sleep(4); if (++sp_ > (1u << 22)) break; } }
            __syncthreads();
        }
        if (MODE == 0) { c.Q = mla + (tok0 + c.P0) * UPW + h * 192; c.qs = UPW; c.K = mla + tok0 * UPW + 768 + h * 128; c.ks = UPW; c.V = mla + tok0 * UPW + 1280 + h * 128; c.vs = UPW;
                         c.K2 = proj + tok0 * PW + PC_KROPE; c.k2s = PW; }
        else if (MODE == 4) { const int cls = qb_raw;
               c.P0 = 0; c.Q = proj + (tok0 + cls) * PW + PC_QB + h * 128; c.K = proj + (tok0 + cls) * PW + PC_KB + h * 128; c.V = proj + (tok0 + cls) * PW + PC_VB + h * 128; c.qs = c.ks = c.vs = 16 * PW;
               c.lse = (float*)(ws + WS_LSE) + (size_t)bh * SEQ + cls; c.lses = 16; }
        else { const int qc = MODE == 1 ? PC_QB : (MODE == 2 ? PC_QC : PC_QD);
               c.Q = proj + (tok0 + c.P0) * PW + qc + h * 128; c.K = proj + tok0 * PW + qc + 512 + h * 128; c.V = proj + tok0 * PW + qc + 1024 + h * 128; c.qs = c.ks = c.vs = PW;
               if (MODE == 1) { c.lse = (float*)(ws + WS_LSE) + (size_t)bh * SEQ + c.P0; c.lses = 1; } }
        c.kmax = 0.f; if (MODE == 2) { c.kbias = (const float*)(ws + WS_KBIAS) + (size_t)bh * SEQ; c.kmax = sqrtf(__uint_as_float(__hip_atomic_load(F.ctl + CW_KMAX + l * 64 + bh, RLX_AGENT))); }
        c.O = y + (tok0 + c.P0) * DM + MODE * 512 + h * 128; c.os = DM;
        if (MODE == 4) { c.O = y + (tok0 + qb_raw) * DM + 512 + h * 128; c.os = 16 * DM; }
        if (MODE >= 3 || F.wave < 4) att::attn_block<MODE, 0>(c, ldsg); else att::attn_block<MODE, 1>(c, ldsg);
        asm volatile("s_waitcnt vmcnt(0)" ::: "memory");
        __syncthreads();
        if (F.tid == 0) { const unsigned a_ = (MODE == 4) ? (__hip_atomic_fetch_add(F.ctl + CW_FDN + l * 64 + bh, 1u, RLX_AGENT), 0u) : __hip_atomic_fetch_add(F.ctl + CW_GNC + ((l * 128 + b * 16 + qb) * 4 + MODE), 1u, RLX_AGENT);
                          F.MISC[18] = a_; ATT_DEQUEUE(); }
        __syncthreads();
        const unsigned arrived = (unsigned)__builtin_amdgcn_readfirstlane((int)F.MISC[18]);
        item = (unsigned)__builtin_amdgcn_readfirstlane((int)F.MISC[16]);
        if (arrived == 3u) {
            __builtin_amdgcn_fence(__ATOMIC_ACQUIRE, "agent"); asm volatile("s_waitcnt vmcnt(0)" ::: "memory");
            bf16* yb = y + (tok0 + c.P0) * DM + MODE * 512 + F.lane * 8;
            for (int r0 = F.wave * 32; r0 < F.wave * 32 + 32; r0 += 8) {
                v4u q[8];
#pragma unroll
                for (int j = 0; j < 8; ++j) q[j] = *(const v4u*)(yb + (size_t)(r0 + j) * DM);
#pragma unroll
                for (int j = 0; j < 8; ++j) { const unsigned w[4] = {q[j].x, q[j].y, q[j].z, q[j].w}; float ssq = 0.f;
#pragma unroll
                    for (int k = 0; k < 4; ++k) { const float lo = bflo(w[k]), hv = bfhi(w[k]); ssq += lo * lo + hv * hv; }
                    ssq = wave_sum(ssq);
                    const float rs = 1.0f / sqrtf(ssq * (1.0f / 512.0f) + EPS); unsigned o[4];
#pragma unroll
                    for (int k = 0; k < 4; ++k) o[k] = pk2(bflo(w[k]) * rs, bfhi(w[k]) * rs);
                    *(v4u*)(yb + (size_t)(r0 + j) * DM) = (v4u){o[0], o[1], o[2], o[3]}; }
            }
        }
        __syncthreads();
        if (MODE == 0 && l + 1 < DEPTH) { p_convert(F, args, l + 1, (bf16*)(ws + (((l + 1) & 1) ? WS_WB1 : WS_WB)), 1); __syncthreads(); }
    }
#undef ATT_DEQUEUE
}

constexpr int N_PHASES = 42;
__global__ void __launch_bounds__(512, 2) fwd_kernel(Args args) {
    extern __shared__ __attribute__((aligned(16))) unsigned char lds[];
    Frame F;
    F.lds = (LAS unsigned char*)lds; F.MISC = (volatile LAS unsigned*)(F.lds + MISC_OFF);
    F.tid = threadIdx.x; F.lane = F.tid & 63; F.wave = __builtin_amdgcn_readfirstlane(F.tid >> 6);
    F.G = gridDim.x; { const int bx = blockIdx.x; F.vcu = (F.G % 8 == 0) ? (bx % 8) * (F.G / 8) + bx / 8 : bx; }
    F.ctl = (unsigned*)(args.ws + WS_CTL);
    for (int u = F.tid; u < (LDS_BYTES - LDSCTL_OFF) / 4; u += 512) ((LAS unsigned*)(F.lds + LDSCTL_OFF))[u] = 0u;
    __syncthreads();
    XcdBarrier bar; bar.bar = F.ctl + CW_BAR; bar.x = 0; bar.st = nullptr;
    if (!MK_PER_PHASE_LAUNCH) bar = xcd_barrier_post(F.ctl + CW_BAR, F.MISC + 8);
    const int lo = args.ph_lo, hi = args.ph_hi;
#define IN(k) (lo <= (k) && (k) < hi)
#define SEAM(k) do { if (!MK_PER_PHASE_LAUNCH && (k) + 1 < hi) xcd_barrier(bar); } while (0)
#define LAUNDER_S(p) asm volatile("" : "+s"(p))
#define PHASE_FRAME_L(l_) Frame Fp = F; { int t_ = threadIdx.x; asm volatile("" : "+v"(t_)); Fp.tid = t_; Fp.lane = t_ & 63; Fp.wave = __builtin_amdgcn_readfirstlane(t_ >> 6); } \
        size_t zoff_ = 0; LAUNDER_S(zoff_); unsigned char* ws = args.ws + zoff_; float* OUT = args.out + zoff_; \
        bf16* WB = (bf16*)(ws + (((l_) & 1) ? WS_WB1 : WS_WB)); bf16* XB = (bf16*)(ws + WS_XB); unsigned char* XL = ws + WS_XL; bf16* PROJ = (bf16*)(ws + WS_PROJ); bf16* MLA = (bf16*)(ws + WS_MLA); \
        bf16* Y = (bf16*)(ws + WS_Y); u64* SS = (u64*)(ws + WS_SS); const f32x2* CS128 = (const f32x2*)(ws + WS_CS128); const f32x2* CS64 = (const f32x2*)(ws + WS_CS64); \
        (void)WB; (void)XB; (void)XL; (void)PROJ; (void)MLA; (void)Y; (void)SS; (void)CS128; (void)CS64; (void)OUT; (void)Fp
#define PHASE_FRAME() PHASE_FRAME_L(l)

    if (IN(0)) { PHASE_FRAME_L(0); p_tables(Fp, args, ws); p_convert(Fp, args, 0, WB); p_rownorm(Fp, args.in[0], XB, XL, SS); SEAM(0); }
    for (int l = 0; l < DEPTH; ++l) {
        const int p0 = 1 + 10 * l;
        if (IN(p0 + 1)) { PHASE_FRAME();
            pg8::Gemm g{(const pg8::bf16_t*)XB, (const pg8::bf16_t*)(WB + WB_IN), M, PW, DM, DM, 1 << 30, 0};
            pg8::StaticOrder S; S.init(M, PW, F.G, (int)blockIdx.x);
            EpiProj E{PROJ, SS + (size_t)(2 * l) * M, CS128, CS64, SS + (size_t)(9 + 2 * l) * M, SS + (size_t)(10 + 2 * l) * M, (float*)(ws + WS_FC), Fp.ctl + CW_LAT + l * 256};
            pg8::gemm_phase<EpiProj, true>(F.lds, g, S, E);
        }
        if (IN(p0 + 3)) { PHASE_FRAME();
            pg8::Gemm g{(const pg8::bf16_t*)PROJ, (const pg8::bf16_t*)(WB + WB_UP), M, UPW, 512, PW, 3, 512};
            pg8::UpOrder S; S.G = F.G; S.c = (int)blockIdx.x;
            if (Fp.wave == 0) { pg8::Unit u_; if (S.next(Fp.lane, u_)) { const unsigned* cp_ = Fp.ctl + CW_LAT + l * 256 + u_.pm * 2 + (u_.pn >= 3 ? 1 : 0); unsigned sp_ = 0;
                                    while (__hip_atomic_load(cp_, RLX_AGENT) < 16u) { __builtin_amdgcn_s_sleep(4); if (++sp_ > (1u << 22)) break; } }
                                __builtin_amdgcn_fence(__ATOMIC_ACQUIRE, "agent"); asm volatile("s_waitcnt vmcnt(0)" ::: "memory"); }
            __syncthreads();
            EpiUp E{MLA, SS + (size_t)(9 + 2 * l) * M, SS + (size_t)(10 + 2 * l) * M, CS64};
            pg8::gemm_phase<EpiUp, true>(F.lds, g, S, E);
            SEAM(p0 + 3);
        }
        if (IN(p0 + 4)) {
            { PHASE_FRAME(); for (int task = (int)gridDim.x - 1 - (int)blockIdx.x; task < 128; task += (int)gridDim.x) p_foxscan(Fp, args, l, ws, task & 31, task >> 5); }
            { PHASE_FRAME(); p_attn_mode<4>(Fp, ws, l, (char*)lds, args); }
            { PHASE_FRAME(); p_attn_mode<0>(Fp, ws, l, (char*)lds, args); }
            { PHASE_FRAME(); p_attn_mode<2>(Fp, ws, l, (char*)lds, args); }
            { PHASE_FRAME(); p_attn_mode<1>(Fp, ws, l, (char*)lds, args); }
            { PHASE_FRAME(); p_attn_mode<3>(Fp, ws, l, (char*)lds, args); }
            if (l + 1 < DEPTH) { PHASE_FRAME_L(l + 1); p_convert(Fp, args, l + 1, WB); }
            SEAM(p0 + 4);
        }
        if (IN(p0 + 6)) { PHASE_FRAME();
            pg8::Gemm g{(const pg8::bf16_t*)Y, (const pg8::bf16_t*)(WB + WB_OUT), M, DM, DM, DM, 1 << 30, 0};
            pg8::StaticOrder S; S.init(M, DM, F.G, (int)blockIdx.x);
            EpiResid E{XB, XL, SS + (size_t)(2 * l + 1) * M};
            pg8::gemm_phase<EpiResid, true, true>(F.lds, g, S, E);
            SEAM(p0 + 6);
        }
#pragma nounroll
        for (int hf = 0; hf < 2; ++hf) {
        if (IN(p0 + 8)) { PHASE_FRAME();
            const size_t ro = (size_t)hf * (M / 2);
            pg8::Gemm g{(const pg8::bf16_t*)(XB + ro * DM), (const pg8::bf16_t*)(WB + WB_GU), M / 2, 2 * FFN, DM, DM, 1 << 30, 0};
            pg8::StaticOrder S; S.init(M / 2, 2 * FFN, F.G, (int)blockIdx.x);
            EpiSwiglu E{PROJ + ro * FFN, SS + (size_t)(2 * l + 1) * M + ro};
            pg8::gemm_phase<EpiSwiglu, true>(F.lds, g, S, E);
            if (!MK_PER_PHASE_LAUNCH) xcd_barrier(bar);
        }
        if (IN(p0 + 9)) { PHASE_FRAME();
            const size_t ro = (size_t)hf * (M / 2);
            pg8::Gemm g{(const pg8::bf16_t*)(PROJ + ro * FFN), (const pg8::bf16_t*)(WB + WB_DN), M / 2, DM, FFN, FFN, 1 << 30, 0};
            pg8::StaticOrder S; S.init(M / 2, DM, F.G, (int)blockIdx.x);
            EpiResid E{XB + ro * DM, XL + ro * DM, SS + (size_t)(2 * l + 2) * M + ro};
            pg8::gemm_phase<EpiResid, true, true>(F.lds, g, S, E);
            if (hf == 1) SEAM(p0 + 9);
        }
        }
    }
    if (IN(41)) { PHASE_FRAME_L(0); p_final(Fp, XB, XL, OUT, args.in[14]); }
#undef IN
#undef SEAM
}

extern "C" void kernel_launch(void* const* d_in, const int* in_sizes, int n_in, void* d_out, int out_size, void* d_ws, size_t ws_size, hipStream_t stream) {
    static int grid = 0;
    if (grid == 0) {
        if (n_in != 15 || out_size != M * DM || ws_size < WS_END) { fprintf(stderr, "kernel_launch: unexpected shapes (n_in %d, out %d, ws %zu; need ws >= %zu); nothing launched\n", n_in, out_size, ws_size, (size_t)WS_END); grid = -1; return; }
        int dev = 0, cus = 0, per_cu = 0;
        if (hipGetDevice(&dev) != hipSuccess || hipDeviceGetAttribute(&cus, hipDeviceAttributeMultiprocessorCount, dev) != hipSuccess) { grid = -1; return; }
        if (hipFuncSetAttribute((const void*)fwd_kernel, hipFuncAttributeMaxDynamicSharedMemorySize, LDS_BYTES) != hipSuccess) { fprintf(stderr, "kernel_launch: hipFuncSetAttribute failed\n"); grid = -1; return; }
        if (hipOccupancyMaxActiveBlocksPerMultiprocessor(&per_cu, (const void*)fwd_kernel, 512, LDS_BYTES) != hipSuccess || per_cu < 1)
            fprintf(stderr, "kernel_launch: note: occupancy query reports %d workgroups per CU\n", per_cu);
        (void)hipGetLastError();
        grid = cus;
    }
    if (grid < 0) return;
    (void)in_sizes;
    if (hipMemsetAsync((char*)d_ws + WS_CTL, 0, CTL_ZERO_BYTES, stream) != hipSuccess) return;
    Args a{};
    for (int i = 0; i < 15; ++i) a.in[i] = (const float*)d_in[i];
    a.out = (float*)d_out; a.ws = (unsigned char*)d_ws;
    for (int i = 0; i < 64; ++i) a.invf128[i] = (double)powf(10000.0f, -(float)(2 * i) / 128.0f);
    for (int i = 0; i < 32; ++i) a.invf64[i] = (double)powf(10000.0f, -(float)(2 * i) / 64.0f);
#if MK_PER_PHASE_LAUNCH
    for (int p = 0; p < N_PHASES; ++p) { a.ph_lo = p; a.ph_hi = p + 1; hipLaunchKernelGGL(fwd_kernel, dim3(grid), dim3(512), LDS_BYTES, stream, a); }
#else
    a.ph_lo = 0; a.ph_hi = N_PHASES;
    hipLaunchKernelGGL(fwd_kernel, dim3(grid), dim3(512), LDS_BYTES, stream, a);
#endif
}
```

```cpp
#include <hip/hip_runtime.h>
#include <hip/hip_bf16.h>
#include <cstdio>
#include <cstdint>
#include <cmath>

#ifndef MK_PER_PHASE_LAUNCH
#define MK_PER_PHASE_LAUNCH 0
#endif

constexpr float EPS = 1e-6f;
typedef unsigned long long u64;
constexpr float SS_FIX = 1048576.0f, SS_UNFIX = 1.0f / 1048576.0f;
__device__ __forceinline__ void ss_add(u64* p, float v) { __hip_atomic_fetch_add(p, (u64)(v * SS_FIX + 0.5f), __ATOMIC_RELAXED, __HIP_MEMORY_SCOPE_AGENT); }
__device__ __forceinline__ float ss_get(const u64* p) { return (float)__hip_atomic_load(p, __ATOMIC_RELAXED, __HIP_MEMORY_SCOPE_AGENT) * SS_UNFIX; }
namespace pg8 {
#define PG8_LAS __attribute__((address_space(3)))
typedef unsigned short bf16_t;
typedef short bf16x8 __attribute__((ext_vector_type(8)));
typedef float f32x4 __attribute__((ext_vector_type(4)));
typedef float f32x2 __attribute__((ext_vector_type(2)));
typedef unsigned u32x4 __attribute__((ext_vector_type(4)));
constexpr int BM = 256, BK = 64, HALF = 128, HTB = HALF * BK * 2, STAGE_BYTES = 8 * HTB, NXCD = 8, WGM = 8;

__host__ __device__ __forceinline__ int lds_byte(int r, int c) { const int st = (r >> 4) * 2 + (c >> 5), rr = r & 15, cc = c & 31, ob = rr * 64 + cc * 2; return st * 1024 + (ob ^ (((ob >> 9) & 1) << 5)); }
__host__ __device__ __forceinline__ void stage_rc(int b, int& R, int& C) { const int st = b / 1024, sb = b % 1024, swz = sb ^ (((sb >> 9) & 1) << 5); R = (st >> 1) * 16 + swz / 64; C = (st & 1) * 32 + (swz % 64) / 2; }
__host__ __device__ __forceinline__ int perm32(int rho) { const int n = rho >> 4, i = rho & 15; return 8 * (i >> 2) + 4 * n + (i & 3); }

struct Unit { int pm, pn; };
struct Gemm { const bf16_t* A; const bf16_t* Bt; int M, N, K, lda, a_split_pn, a_split_off; };

struct StaticOrder {
    int nM, nN, nwg, G, c;
    __host__ __device__ void init(int M, int N, int G_, int c_) { nM = M / BM; nN = N / BM; nwg = nM * nN; G = G_; c = c_; }
    __host__ __device__ __forceinline__ bool next(int i, Unit& u) const {
        const long L = (long)i * G + c; if (L >= nwg) return false;
        int wgid = (int)L; { const int q = nwg / NXCD, r = nwg % NXCD, xcd = wgid % NXCD, off = wgid / NXCD; wgid = (xcd < r ? xcd * (q + 1) : r * (q + 1) + (xcd - r) * q) + off; }
        const int nig = WGM * nN, gid = wgid / nig, fm = gid * WGM, gsz = (nM - fm) < WGM ? (nM - fm) : WGM;
        u.pm = fm + ((wgid % nig) % gsz); u.pn = (wgid % nig) / gsz; return true;
    }
};

struct UpOrder {
    int G, c;
    __host__ __device__ __forceinline__ bool next(int i, Unit& u) const {
        if (G == 256) { const int xcd = c & 7, rank = c >> 3, n = rank < 16 ? 2 : 5, first = rank < 16 ? 2 * rank : 32 + 5 * (rank - 16);
            if (i >= n) return false; const int j = first + i; u.pm = 16 * xcd + j / 7; u.pn = j % 7; return true; }
        const long L = (long)i * G + c; if (L >= 896) return false; u.pm = (int)(L / 7); u.pn = (int)(L % 7); return true;
    }
};

__device__ __forceinline__ unsigned cvt_pk_bf16(float lo, float hi) { unsigned r; asm volatile("v_cvt_pk_bf16_f32 %0, %1, %2" : "=v"(r) : "v"(lo), "v"(hi)); return r; }

template <class Epi, bool ALIGN_EPI, bool REVK = false, class Order = StaticOrder>
__device__ __forceinline__ void gemm_phase(PG8_LAS unsigned char* lds, const Gemm g, const Order& S, const Epi& E) {
    int tid = threadIdx.x; asm volatile("" : "+v"(tid));
    const int wid = __builtin_amdgcn_readfirstlane(tid >> 6), lane = tid & 63, wr = wid >> 2, wc = wid & 3, fr = lane & 15, fq = lane >> 4;
    const int K = g.K, nt = K / BK, lda = g.lda;
    unsigned voffA[2], voffB[2];
#pragma unroll
    for (int i = 0; i < 2; ++i) { int R, C; stage_rc(tid * 16 + i * 8192, R, C); const int Rb = Epi::PERM ? ((R & ~31) + perm32(R & 31)) : R;
        voffA[i] = (unsigned)(R * lda + C) * 2u; voffB[i] = (unsigned)(Rb * K + C) * 2u; }
    const long kstep = REVK ? -(long)(BK * 2) : (long)(BK * 2); const size_t k0off = REVK ? (size_t)(nt - 1) * (BK * 2) : (size_t)0;
    const size_t hstepA = (size_t)HALF * lda * 2, hstepB = (size_t)HALF * K * 2;
    const size_t tstepA = 2 * hstepA, tstepB = 2 * hstepB;
    const unsigned ldsw = (unsigned)wid * 1024u;
    const int aoff = lds_byte(wr * 64 + fr, fq * 8), boff = lds_byte(wc * 32 + fr, fq * 8);
#define PG8_AOF(u) ((const char*)g.A + k0off + (size_t)(u).pm * tstepA + ((u).pn >= g.a_split_pn ? (size_t)g.a_split_off * 2 : (size_t)0))
#define PG8_BOF(u) ((const char*)g.Bt + k0off + (size_t)(u).pn * tstepB)
#define PG8_SA(b, h) (((b) * 2 + (h)) * HTB)
#define PG8_SB(b, h) ((4 + (b) * 2 + (h)) * HTB)
#define PG8_STAGE(bufoff, gbase, voff) do { _Pragma("unroll") for (int _i = 0; _i < 2; ++_i) \
        __builtin_amdgcn_global_load_lds((const unsigned*)((const char*)(gbase) + (voff)[_i]), (PG8_LAS unsigned*)(lds + (bufoff) + ldsw + _i * 8192), 16, 0, 0); } while (0)
#define PG8_LDA(dst, b, h) do { _Pragma("unroll") for (int m = 0; m < 4; ++m) _Pragma("unroll") for (int k = 0; k < 2; ++k) dst[m][k] = *(const PG8_LAS bf16x8*)(lds + PG8_SA(b, h) + aoff + m * 2048 + k * 1024); } while (0)
#define PG8_LDB(dst, b, h) do { _Pragma("unroll") for (int n = 0; n < 2; ++n) _Pragma("unroll") for (int k = 0; k < 2; ++k) dst[n][k] = *(const PG8_LAS bf16x8*)(lds + PG8_SB(b, h) + boff + n * 2048 + k * 1024); } while (0)
#define PG8_MMA(ai, bj, At, Bt) do { __builtin_amdgcn_s_setprio(1); _Pragma("unroll") for (int m = 0; m < 4; ++m) _Pragma("unroll") for (int n = 0; n < 2; ++n) _Pragma("unroll") for (int k = 0; k < 2; ++k) \
        acc[ai][bj][m][n] = __builtin_amdgcn_mfma_f32_16x16x32_bf16(Bt[n][k], At[m][k], acc[ai][bj][m][n], 0, 0, 0); __builtin_amdgcn_s_setprio(0); } while (0)
#define PG8_WAIT_V(n) asm volatile("s_waitcnt vmcnt(" #n ")" ::: "memory")
#define PG8_WAIT_L(n) asm volatile("s_waitcnt lgkmcnt(" #n ")" ::: "memory")
#define PG8_BAR __builtin_amdgcn_s_barrier()
#define PG8_SCHED __builtin_amdgcn_sched_barrier(0)
    Unit cur, nxt; int ui = 0;
    if (!S.next(0, cur)) return;
    PG8_LAS float* rtab = (PG8_LAS float*)(lds + STAGE_BYTES);
    if constexpr (Epi::ROWS) { if (tid < 256) rtab[tid] = Epi::RS_MUL / sqrtf(ss_get(E.row_ss(cur) + cur.pm * 256 + tid) * Epi::RS_INV + EPS); }
    f32x4 acc[2][2][4][2];
    { float z = 0.f; asm volatile("" : "+v"(z));
#pragma unroll
    for (int a = 0; a < 2; ++a)
#pragma unroll
        for (int b = 0; b < 2; ++b)
#pragma unroll
            for (int m = 0; m < 4; ++m)
#pragma unroll
                for (int n = 0; n < 2; ++n) acc[a][b][m][n] = (f32x4){z, z, z, z}; }
    bf16x8 At[4][2], B0[2][2], B1[2][2];
    const char* cA = PG8_AOF(cur); const char* cB = PG8_BOF(cur);
    PG8_STAGE(PG8_SB(0, 0), cB, voffB); PG8_STAGE(PG8_SB(0, 1), cB + hstepB, voffB); PG8_STAGE(PG8_SA(0, 0), cA, voffA); PG8_STAGE(PG8_SA(0, 1), cA + hstepA, voffA);
    if (wr == 1) PG8_BAR;
    PG8_WAIT_V(2); PG8_BAR;
    PG8_STAGE(PG8_SB(1, 0), cB + kstep, voffB); PG8_STAGE(PG8_SA(1, 0), cA + kstep, voffA); PG8_STAGE(PG8_SB(1, 1), cB + hstepB + kstep, voffB);
    PG8_WAIT_V(6); PG8_BAR;
    for (;;) {
        const bool has_next = S.next(ui + 1, nxt);
        const char* nA = has_next ? PG8_AOF(nxt) : cA; const char* nB = has_next ? PG8_BOF(nxt) : cB;
        for (int t = 0; t < nt; t += 2) {
            const bool last = (t == nt - 2);
            const char* a1 = cA + (long)(t + 1) * kstep;
            const char* a2 = last ? nA : cA + (long)(t + 2) * kstep; const char* b2 = last ? nB : cB + (long)(t + 2) * kstep;
            const char* a3 = a2 + kstep; const char* b3 = b2 + kstep;
            PG8_LDB(B0, 0, 0); PG8_LDB(B1, 0, 1); PG8_SCHED; PG8_LDA(At, 0, 0); PG8_STAGE(PG8_SA(1, 1), a1 + hstepA, voffA);
            PG8_WAIT_V(8); PG8_WAIT_L(0); PG8_BAR; PG8_MMA(0, 0, At, B0); PG8_MMA(0, 1, At, B1); PG8_BAR; PG8_SCHED;
            PG8_LDA(At, 0, 1); PG8_STAGE(PG8_SB(0, 0), b2, voffB); PG8_STAGE(PG8_SB(0, 1), b2 + hstepB, voffB); PG8_STAGE(PG8_SA(0, 0), a2, voffA);
            PG8_WAIT_V(8); PG8_WAIT_L(0); PG8_BAR; PG8_MMA(1, 0, At, B0); PG8_MMA(1, 1, At, B1); PG8_BAR; PG8_SCHED;
            PG8_LDB(B0, 1, 0); PG8_LDB(B1, 1, 1); PG8_SCHED; PG8_LDA(At, 1, 0); PG8_STAGE(PG8_SA(0, 1), a2 + hstepA, voffA);
            PG8_WAIT_V(8); PG8_WAIT_L(0); PG8_BAR; PG8_MMA(0, 0, At, B0); PG8_MMA(0, 1, At, B1); PG8_BAR; PG8_SCHED;
            PG8_LDA(At, 1, 1); PG8_STAGE(PG8_SB(1, 0), b3, voffB); PG8_STAGE(PG8_SB(1, 1), b3 + hstepB, voffB); PG8_STAGE(PG8_SA(1, 0), a3, voffA);
            PG8_WAIT_V(8); PG8_WAIT_L(0); PG8_BAR; PG8_MMA(1, 0, At, B0); PG8_MMA(1, 1, At, B1); PG8_BAR; PG8_SCHED;
        }
        if constexpr (ALIGN_EPI) { if (wr == 0) PG8_BAR; }
        if constexpr (Epi::ROWS) {
            float nss_ = 0.f; if (has_next && tid < 256) nss_ = ss_get(E.row_ss(nxt) + nxt.pm * 256 + tid);
            E(acc, cur, wr, wc, fr, fq, rtab + (ui & 1) * 256);
            if (has_next && tid < 256) rtab[((ui + 1) & 1) * 256 + tid] = Epi::RS_MUL / sqrtf(nss_ * Epi::RS_INV + EPS);
        } else E(acc, cur, wr, wc, fr, fq);
        if (!has_next) break;
        { float z = 0.f; asm volatile("" : "+v"(z));
#pragma unroll
        for (int a = 0; a < 2; ++a)
#pragma unroll
            for (int b = 0; b < 2; ++b)
#pragma unroll
                for (int m = 0; m < 4; ++m)
#pragma unroll
                    for (int n = 0; n < 2; ++n) acc[a][b][m][n] = (f32x4){z, z, z, z}; }
        cur = nxt; cA = nA; cB = nB; ++ui;
        if constexpr (ALIGN_EPI) { if (wr == 1) PG8_BAR; }
    }
    PG8_WAIT_V(0);
    if constexpr (!ALIGN_EPI) { if (wr == 0) PG8_BAR; }
    PG8_BAR;
#undef PG8_AOF
#undef PG8_BOF
#undef PG8_SA
#undef PG8_SB
#undef PG8_STAGE
#undef PG8_LDA
#undef PG8_LDB
#undef PG8_MMA
#undef PG8_WAIT_V
#undef PG8_WAIT_L
#undef PG8_BAR
#undef PG8_SCHED
}
}

constexpr int NB = 8, SEQ = 4096, DM = 2048, DEPTH = 4, M = NB * SEQ;
constexpr int PW = 5888;
constexpr int IN_W = 5700, FFN = 5632, UPW = 1792;
constexpr int PC_QLAT = 0, PC_KVLAT = 512, PC_KROPE = 1024, PC_FC = 1088, PC_PAD0 = 1092, PC_QB = 1280, PC_KB = 1792, PC_VB = 2304,
              PC_QC = 2816, PC_KC = 3328, PC_VC = 3840, PC_QD = 4352, PC_KD = 4864, PC_VD = 5376;
constexpr size_t WB_IN = 0, WB_UP = WB_IN + (size_t)PW * DM, WB_OUT = WB_UP + (size_t)UPW * 512, WB_GU = WB_OUT + (size_t)DM * DM,
                 WB_DN = WB_GU + (size_t)2 * FFN * DM, WB_END = WB_DN + (size_t)DM * FFN;
constexpr size_t MiB = 1u << 20;
constexpr size_t WS_CTL = 0;
constexpr size_t WS_SS = 1 * MiB;
constexpr size_t CTL_ZERO_BYTES = 6 * MiB;
constexpr size_t WS_CS128 = 6 * MiB;
constexpr size_t WS_CS64 = 8 * MiB;
constexpr size_t WS_KBIAS = 9 * MiB;
constexpr size_t WS_FC = 9 * MiB + 512 * 1024;
constexpr size_t WS_WB = 10 * MiB;
constexpr size_t WS_XB = 114 * MiB;
constexpr size_t WS_PROJ = 242 * MiB;
constexpr size_t WS_MLA = 610 * MiB;
constexpr size_t WS_Y = 722 * MiB;
constexpr size_t WS_WB1 = 850 * MiB;
constexpr size_t WS_XL = 954 * MiB;
constexpr size_t WS_LSE = 1018 * MiB;
constexpr size_t WS_END = 1019 * MiB;
static_assert(WS_SS + (size_t)17 * M * 8 <= CTL_ZERO_BYTES && WS_WB + WB_END * 2 <= WS_XB && WS_XB + (size_t)M * DM * 2 <= WS_PROJ && WS_PROJ + (size_t)M * PW * 2 <= WS_MLA && WS_MLA + (size_t)M * UPW * 2 <= WS_Y && WS_Y + (size_t)M * DM * 2 <= WS_WB1 && WS_WB1 + WB_END * 2 <= WS_XL && WS_XL + (size_t)M * DM <= WS_END, "ws map");
constexpr int CW_BAR = 4096;
constexpr int CW_ATTQ = 16384;
constexpr int CW_FDN = 81920;
constexpr int CW_GNC = 65536;
constexpr int CW_KMAX = 49152;
constexpr int CW_LAT = 90112;
constexpr int CW_SCN = 94208;
constexpr int CW_CVTQ = 32768;

constexpr int RING_BYTES = 131072, LDS_BYTES = 147456, LDSCTL_OFF = LDS_BYTES - 1024, MISC_OFF = LDSCTL_OFF + 320;

#define GAS __attribute__((address_space(1)))
#define LAS __attribute__((address_space(3)))
typedef unsigned short bf16;
typedef unsigned v4u __attribute__((ext_vector_type(4)));
typedef unsigned v2u __attribute__((ext_vector_type(2)));
typedef float f32x4 __attribute__((ext_vector_type(4)));
typedef float f32x2 __attribute__((ext_vector_type(2)));
typedef short bf16x8 __attribute__((ext_vector_type(8)));
typedef GAS unsigned gu32;
#define RLX_AGENT __ATOMIC_RELAXED, __HIP_MEMORY_SCOPE_AGENT
#define LDS_WAIT() asm volatile("s_waitcnt lgkmcnt(0)" ::: "memory")
#define VM_WAIT() asm volatile("s_waitcnt vmcnt(0)" ::: "memory")
__device__ __forceinline__ unsigned f2bf(float f) { unsigned u = __builtin_bit_cast(unsigned, f); return (u + 0x7fffu + ((u >> 16) & 1u)) >> 16; }
__device__ __forceinline__ unsigned pk2(float lo, float hi) { return f2bf(lo) | (f2bf(hi) << 16); }
__device__ __forceinline__ float bflo(unsigned w) { return __builtin_bit_cast(float, w << 16); }
__device__ __forceinline__ float bfhi(unsigned w) { return __builtin_bit_cast(float, w & 0xffff0000u); }
__device__ __forceinline__ void st16_wt(void* p, v4u w) { asm volatile("global_store_dwordx4 %0, %1, off sc1\n\ts_nop 1" :: "v"(p), "v"(w) : "memory"); }

constexpr float RES_TRUNC_GAIN = 1.0f;
template <int T> __device__ __forceinline__ float res_join(unsigned hi, unsigned ext) {
    return __uint_as_float(__builtin_amdgcn_perm(hi, ext, ((T & 1) ? 0x07060000u : 0x05040000u) | ((unsigned)T << 8) | 0x0Cu));
}
__device__ __forceinline__ void res_split4(float a, float b, float c, float d, unsigned& w0, unsigned& w1, unsigned& ext) {
    const unsigned ua = __float_as_uint(a), ub = __float_as_uint(b), uc = __float_as_uint(c), ud = __float_as_uint(d);
    w0 = __builtin_amdgcn_perm(ub, ua, 0x07060302u); w1 = __builtin_amdgcn_perm(ud, uc, 0x07060302u);
    ext = __builtin_amdgcn_perm(ub, ua, 0x0C0C0501u) | __builtin_amdgcn_perm(ud, uc, 0x05010C0Cu);
}
__device__ __forceinline__ int xl_idx(int c) { return (c & ~255) | (((c >> 5) & 3) << 6) | (((c >> 3) & 3) << 4) | (((c >> 7) & 1) << 3) | (c & 7); }
struct EpiProj {
    static constexpr bool PERM = true, ROWS = true; static constexpr float RS_INV = 1.0f / 2048.0f, RS_MUL = RES_TRUNC_GAIN;
    __device__ __forceinline__ const u64* row_ss(const pg8::Unit&) const { return ss; }
    bf16* O; const u64* ss; const f32x2* cs128; const f32x2* cs64; u64* ssq; u64* sskv; float* fc; unsigned* latc;
    __device__ __forceinline__ void operator()(const pg8::f32x4 (&acc)[2][2][4][2], const pg8::Unit& u, int wr, int wc, int fr, int fq, const PG8_LAS float* rt) const {
        const int row0 = u.pm * 256 + wr * 64 + fr, ct = wc * 32 + 8 * fq;
        const bool rope_b = (u.pn >= 5 && u.pn <= 8);
        const bool rope_a = (u.pn == 4) && (ct < 64);
#pragma unroll
        for (int ai = 0; ai < 2; ++ai)
#pragma unroll
            for (int m = 0; m < 4; ++m) {
                const int r = row0 + ai * 128 + m * 16; const int pos = r & (SEQ - 1); const float rs = rt[wr * 64 + fr + ai * 128 + m * 16]; float sq = 0.f;
                bf16* rowp = O + (size_t)r * PW + u.pn * 256 + ct;
#pragma unroll
                for (int bj = 0; bj < 2; ++bj) {
                    f32x4 v0 = acc[ai][bj][m][0] * rs, v1 = acc[ai][bj][m][1] * rs;
                    if (rope_b || (rope_a && bj == 0)) {
                        const int c = ct + bj * 128;
                        const f32x2* tp = rope_b ? (cs128 + (size_t)pos * 64 + ((c & 127) >> 1)) : (cs64 + (size_t)pos * 32 + (c >> 1));
                        const f32x4 t0 = *(const f32x4*)tp, t1 = *(const f32x4*)(tp + 2);
                        f32x4 w0, w1;
                        w0[0] = v0[0] * t0[0] - v0[1] * t0[1]; w0[1] = v0[0] * t0[1] + v0[1] * t0[0];
                        w0[2] = v0[2] * t0[2] - v0[3] * t0[3]; w0[3] = v0[2] * t0[3] + v0[3] * t0[2];
                        w1[0] = v1[0] * t1[0] - v1[1] * t1[1]; w1[1] = v1[0] * t1[1] + v1[1] * t1[0];
                        w1[2] = v1[2] * t1[2] - v1[3] * t1[3]; w1[3] = v1[2] * t1[3] + v1[3] * t1[2];
                        v0 = w0; v1 = w1;
                    }
                    v4u w; w.x = pg8::cvt_pk_bf16(v0[0], v0[1]); w.y = pg8::cvt_pk_bf16(v0[2], v0[3]); w.z = pg8::cvt_pk_bf16(v1[0], v1[1]); w.w = pg8::cvt_pk_bf16(v1[2], v1[3]);
                    if (u.pn < 4) st16_wt(rowp + bj * 128, w); else *(v4u*)(rowp + bj * 128) = w;
                    if (u.pn < 4) sq += (v0[0] * v0[0] + v0[1] * v0[1]) + (v0[2] * v0[2] + v0[3] * v0[3]) + (v1[0] * v1[0] + v1[1] * v1[1]) + (v1[2] * v1[2] + v1[3] * v1[3]);
                    if (u.pn == 4 && bj == 0 && ct == 64) *(f32x4*)(fc + (size_t)r * 4) = v0;
                }
                if (u.pn < 4) { sq += __shfl_xor(sq, 16); sq += __shfl_xor(sq, 32); if (fq == 0) ss_add((u.pn < 2 ? ssq : sskv) + r, sq); }
            }
        if (u.pn < 4) { asm volatile("s_waitcnt vmcnt(0)" ::: "memory");
            if (fr == 0 && fq == 0) __hip_atomic_fetch_add(latc + u.pm * 2 + (u.pn >> 1), 1u, __ATOMIC_RELAXED, __HIP_MEMORY_SCOPE_AGENT); }
    }
};
struct EpiUp {
    static constexpr bool PERM = true, ROWS = true; static constexpr float RS_INV = 1.0f / 512.0f, RS_MUL = 1.0f;
    __device__ __forceinline__ const u64* row_ss(const pg8::Unit& u) const { return u.pn < 3 ? ssq : sskv; }
    bf16* O; const u64* ssq; const u64* sskv; const f32x2* cs64;
    __device__ __forceinline__ void operator()(const pg8::f32x4 (&acc)[2][2][4][2], const pg8::Unit& u, int wr, int wc, int fr, int fq, const PG8_LAS float* rt) const {
        const int row0 = u.pm * 256 + wr * 64 + fr, ct = wc * 32 + 8 * fq;
        const bool isq = u.pn < 3;
#pragma unroll
        for (int ai = 0; ai < 2; ++ai)
#pragma unroll
            for (int m = 0; m < 4; ++m) {
                const int r = row0 + ai * 128 + m * 16; const int pos = r & (SEQ - 1); const float rs = rt[wr * 64 + fr + ai * 128 + m * 16];
                bf16* rowp = O + (size_t)r * UPW + u.pn * 256 + ct;
#pragma unroll
                for (int bj = 0; bj < 2; ++bj) {
                    f32x4 v0 = acc[ai][bj][m][0] * rs, v1 = acc[ai][bj][m][1] * rs;
                    const int c = u.pn * 256 + ct + bj * 128;
                    const int e = c % 192;
                    if (isq && e >= 128) {
                        const f32x2* tp = cs64 + (size_t)pos * 32 + ((e - 128) >> 1);
                        const f32x4 t0 = *(const f32x4*)tp, t1 = *(const f32x4*)(tp + 2);
                        f32x4 w0, w1;
                        w0[0] = v0[0] * t0[0] - v0[1] * t0[1]; w0[1] = v0[0] * t0[1] + v0[1] * t0[0];
                        w0[2] = v0[2] * t0[2] - v0[3] * t0[3]; w0[3] = v0[2] * t0[3] + v0[3] * t0[2];
                        w1[0] = v1[0] * t1[0] - v1[1] * t1[1]; w1[1] = v1[0] * t1[1] + v1[1] * t1[0];
                        w1[2] = v1[2] * t1[2] - v1[3] * t1[3]; w1[3] = v1[2] * t1[3] + v1[3] * t1[2];
                        v0 = w0; v1 = w1;
                    }
                    v4u w; w.x = pg8::cvt_pk_bf16(v0[0], v0[1]); w.y = pg8::cvt_pk_bf16(v0[2], v0[3]); w.z = pg8::cvt_pk_bf16(v1[0], v1[1]); w.w = pg8::cvt_pk_bf16(v1[2], v1[3]);
                    *(v4u*)(rowp + bj * 128) = w;
                }
            }
    }
};
struct EpiResid {
    static constexpr bool PERM = true, ROWS = false;
    bf16* xb; unsigned char* xl; u64* ss;
    __device__ __forceinline__ void operator()(const pg8::f32x4 (&acc)[2][2][4][2], const pg8::Unit& u, int wr, int wc, int fr, int fq) const {
        const int row0 = u.pm * 256 + wr * 64 + fr, col0 = u.pn * 256 + wc * 32 + 8 * fq, xoff = u.pn * 256 + wc * 64 + fq * 16;
#pragma unroll
        for (int ai = 0; ai < 2; ++ai) {
            v4u b[4][2];
#pragma unroll
            for (int m = 0; m < 4; ++m)
#pragma unroll
                for (int bj = 0; bj < 2; ++bj) b[m][bj] = *(const v4u*)(xb + (size_t)(row0 + ai * 128 + m * 16) * DM + col0 + bj * 128);
            float sqmine = 0.f;
#pragma unroll
            for (int m = 0; m < 4; ++m) { const int r = row0 + ai * 128 + m * 16; const size_t off = (size_t)r * DM + col0; float sq = 0.f;
#pragma unroll
                for (int bj = 0; bj < 2; ++bj) {
                    const v4u q = b[m][bj];
                    const f32x4 v0 = (f32x4){bflo(q.x), bfhi(q.x), bflo(q.y), bfhi(q.y)} + acc[ai][bj][m][0], v1 = (f32x4){bflo(q.z), bfhi(q.z), bflo(q.w), bfhi(q.w)} + acc[ai][bj][m][1];
                    v4u w; w.x = pg8::cvt_pk_bf16(v0[0], v0[1]); w.y = pg8::cvt_pk_bf16(v0[2], v0[3]); w.z = pg8::cvt_pk_bf16(v1[0], v1[1]); w.w = pg8::cvt_pk_bf16(v1[2], v1[3]);
                    *(v4u*)(xb + off + bj * 128) = w;
                    sq += (v0[0] * v0[0] + v0[1] * v0[1]) + (v0[2] * v0[2] + v0[3] * v0[3]) + (v1[0] * v1[0] + v1[1] * v1[1]) + (v1[2] * v1[2] + v1[3] * v1[3]);
                }
                sq += __shfl_xor(sq, 16); sq += __shfl_xor(sq, 32); sqmine = (fq == m) ? sq : sqmine; }
            ss_add(ss + row0 + ai * 128 + fq * 16, sqmine);
            asm volatile("" ::: "memory");
        }
        (void)xl; (void)xoff;
    }
};
struct EpiSwiglu {
    static constexpr bool PERM = true, ROWS = true; static constexpr float RS_INV = 1.0f / 2048.0f, RS_MUL = RES_TRUNC_GAIN;
    __device__ __forceinline__ const u64* row_ss(const pg8::Unit&) const { return ss; }
    bf16* O; const u64* ss;
    __device__ __forceinline__ void operator()(const pg8::f32x4 (&acc)[2][2][4][2], const pg8::Unit& u, int wr, int wc, int fr, int fq, const PG8_LAS float* rt) const {
        const int row0 = u.pm * 256 + wr * 64 + fr, col0 = u.pn * 128 + wc * 32 + 8 * fq;
#pragma unroll
        for (int ai = 0; ai < 2; ++ai)
#pragma unroll
            for (int m = 0; m < 4; ++m) {
                const int r = row0 + ai * 128 + m * 16; const float rs = rt[wr * 64 + fr + ai * 128 + m * 16];
                float h[8];
#pragma unroll
                for (int n = 0; n < 2; ++n)
#pragma unroll
                    for (int j = 0; j < 4; ++j) { const float gt = acc[ai][0][m][n][j] * rs, up = acc[ai][1][m][n][j] * rs;
                        const float sg = __builtin_amdgcn_rcpf(1.0f + __builtin_amdgcn_exp2f(-1.4426950408889634f * gt)); h[n * 4 + j] = gt * sg * up; }
                v4u w; w.x = pg8::cvt_pk_bf16(h[0], h[1]); w.y = pg8::cvt_pk_bf16(h[2], h[3]); w.z = pg8::cvt_pk_bf16(h[4], h[5]); w.w = pg8::cvt_pk_bf16(h[6], h[7]);
                *(v4u*)(O + (size_t)r * FFN + col0) = w;
            }
    }
};

namespace att {
typedef short s16x4 __attribute__((ext_vector_type(4)));
typedef float f32x16 __attribute__((ext_vector_type(16)));
constexpr int SHM_V = 16384, SHM_K = 16384, K2ROW = 144, SHM_K2 = 64 * K2ROW;
constexpr int OFF_V = 0, OFF_K = 2 * SHM_V, OFF_WS = OFF_K + 2 * SHM_K, OFF_FLG = OFF_WS + 8 * 256, OFF_K2 = OFF_FLG + 64, OFF_KB = OFF_K2, OFF_Q2 = OFF_K2 + 2 * SHM_K2, ATT_LDS = OFF_K2 + 8 * 8192;
static_assert(OFF_Q2 + 8 * 4096 <= ATT_LDS && OFF_KB + 16384 <= ATT_LDS && ATT_LDS <= LDSCTL_OFF && (OFF_K2 % 16) == 0, "attention LDS");
#define KSWZ(row, colB) ((row) * 256 + ((colB) ^ (((row) & 7) << 4)))
#define SBAR() __builtin_amdgcn_sched_barrier(0)
__device__ __forceinline__ int v_st(int k, int c) { const int kk = (k & ~0xC) | ((k & 4) << 1) | ((k & 8) >> 1); return ((kk >> 3) * 4 + (c >> 5)) * 512 + ((kk & 7) * 32 + (c & 31)) * 2; }
__device__ __forceinline__ int v_rd_base(int lane) { return ((lane & 3) << 3) | (((lane >> 2) & 3) << 6) | (((lane >> 4) & 1) << 5) | (((lane >> 5) & 1) << 8); }
constexpr int v_rd_off(int d0, int ks, int half) { return d0 * 512 + ks * 4096 + half * 2048; }
__device__ __forceinline__ int crow(int r, int hi) { return (r & 3) + 8 * (r >> 2) + 4 * hi; }
__device__ __forceinline__ unsigned cvtpk(float lo, float hi) { unsigned r; asm volatile("v_cvt_pk_bf16_f32 %0, %1, %2" : "=v"(r) : "v"(lo), "v"(hi)); return r; }

template <int KB, bool MLA, int NQR>
__device__ __forceinline__ void qkt(f32x16& p0, f32x16& p1, const char* lds, int r32, int hi, const bf16x8* qr, const char* q2p) {
    p0 = f32x16{}; p1 = f32x16{};
    const char* kb[4];
#pragma unroll
    for (int dd = 0; dd < 4; ++dd) kb[dd] = lds + OFF_K + KB * SHM_K + KSWZ(r32, (dd * 16 + hi * 8) * 2);
#pragma unroll
    for (int d0 = 0; d0 < 8; ++d0) { const char* a = kb[d0 & 3] + (d0 >> 2) * 128;
        const bf16x8 b0 = *reinterpret_cast<const bf16x8*>(a);
        const bf16x8 b1 = *reinterpret_cast<const bf16x8*>(a + 32 * 256);
        bf16x8 q; if (d0 < NQR) q = qr[d0 < NQR ? d0 : 0]; else q = *reinterpret_cast<const bf16x8*>(q2p + (d0 - NQR) * 1024);
        p0 = __builtin_amdgcn_mfma_f32_32x32x16_bf16(b0, q, p0, 0, 0, 0);
        p1 = __builtin_amdgcn_mfma_f32_32x32x16_bf16(b1, q, p1, 0, 0, 0); }
    if constexpr (MLA) {
        const char* k2 = lds + OFF_K2 + KB * SHM_K2 + r32 * K2ROW + hi * 16;
#pragma unroll
        for (int dd = 0; dd < 4; ++dd) {
            const bf16x8 b0 = *reinterpret_cast<const bf16x8*>(k2 + dd * 32);
            const bf16x8 b1 = *reinterpret_cast<const bf16x8*>(k2 + 32 * K2ROW + dd * 32);
            const bf16x8 q2 = *reinterpret_cast<const bf16x8*>(q2p + (8 - NQR + dd) * 1024);
            p0 = __builtin_amdgcn_mfma_f32_32x32x16_bf16(b0, q2, p0, 0, 0, 0);
            p1 = __builtin_amdgcn_mfma_f32_32x32x16_bf16(b1, q2, p1, 0, 0, 0); }
    }
}
template <int VB>
__device__ __forceinline__ void pv_tile(f32x16* o, int vb0, bf16x8 pa0, bf16x8 pa1, bf16x8 pa2, bf16x8 pa3) {
#define TRRD(dst, off) asm volatile("ds_read_b64_tr_b16 %0, %1 offset:%2" : "=&v"(dst) : "v"(vb0), "i"(off) : "memory")
#define PV_D0(d0) do { s16x4 l0, l1, l2, l3, h0, h1, h2, h3; constexpr int b_ = OFF_V + VB * SHM_V + v_rd_off(d0, 0, 0); \
        TRRD(l0, b_); TRRD(h0, b_ + 2048); TRRD(l1, b_ + 4096); TRRD(h1, b_ + 6144); TRRD(l2, b_ + 8192); TRRD(h2, b_ + 10240); TRRD(l3, b_ + 12288); TRRD(h3, b_ + 14336); \
        asm volatile("s_waitcnt lgkmcnt(0)" ::: "memory"); SBAR(); \
        o[d0] = __builtin_amdgcn_mfma_f32_32x32x16_bf16(pa0, (bf16x8){l0[0], l0[1], l0[2], l0[3], h0[0], h0[1], h0[2], h0[3]}, o[d0], 0, 0, 0); \
        o[d0] = __builtin_amdgcn_mfma_f32_32x32x16_bf16(pa1, (bf16x8){l1[0], l1[1], l1[2], l1[3], h1[0], h1[1], h1[2], h1[3]}, o[d0], 0, 0, 0); \
        o[d0] = __builtin_amdgcn_mfma_f32_32x32x16_bf16(pa2, (bf16x8){l2[0], l2[1], l2[2], l2[3], h2[0], h2[1], h2[2], h2[3]}, o[d0], 0, 0, 0); \
        o[d0] = __builtin_amdgcn_mfma_f32_32x32x16_bf16(pa3, (bf16x8){l3[0], l3[1], l3[2], l3[3], h3[0], h3[1], h3[2], h3[3]}, o[d0], 0, 0, 0); } while (0)
    PV_D0(0); PV_D0(1); PV_D0(2); PV_D0(3);
#undef PV_D0
#undef TRRD
}
__device__ __forceinline__ void pack_p(const f32x16& p0, const f32x16& p1, bf16x8& pa0, bf16x8& pa1, bf16x8& pa2, bf16x8& pa3) {
#define PK4(P, B_, OUT) do { unsigned a0 = cvtpk(P[B_+0], P[B_+1]), a1 = cvtpk(P[B_+2], P[B_+3]); \
        unsigned b0 = cvtpk(P[B_+4], P[B_+5]), b1 = cvtpk(P[B_+6], P[B_+7]); \
        auto r0 = __builtin_amdgcn_permlane32_swap(a0, b0, false, false); auto r1 = __builtin_amdgcn_permlane32_swap(a1, b1, false, false); \
        v4u w = {r0[0], r1[0], r0[1], r1[1]}; OUT = *reinterpret_cast<bf16x8*>(&w); } while (0)
    PK4(p0, 0, pa0); PK4(p0, 8, pa1); PK4(p1, 0, pa2); PK4(p1, 8, pa3);
#undef PK4
}
template <int MODE>
__device__ __forceinline__ void partialSM(f32x16& p0, f32x16& p1, float& m_reg, float& alpha) {
    constexpr float SCALE = (MODE == 0) ? 0.07216878364870323f : 0.08838834764831845f;
    constexpr float C2 = 1.4426950408889634f * SCALE; constexpr float THR = 8.f;
    float pmax = p0[0];
#pragma unroll
    for (int r = 1; r < 16; ++r) pmax = fmaxf(pmax, p0[r]);
#pragma unroll
    for (int r = 0; r < 16; ++r) pmax = fmaxf(pmax, p1[r]);
    { auto rr = __builtin_amdgcn_permlane32_swap(__float_as_uint(pmax), __float_as_uint(pmax), false, false);
      pmax = fmaxf(__uint_as_float(rr[0]), __uint_as_float(rr[1])); }
    float mn;
    if (__builtin_expect(__all((pmax - m_reg) * SCALE <= THR), 1)) { mn = m_reg; alpha = 1.f; }
    else { mn = fmaxf(m_reg, pmax); alpha = __builtin_amdgcn_exp2f((m_reg - mn) * C2); m_reg = mn; }
    const float mnL = -mn * C2;
#pragma unroll
    for (int r = 0; r < 16; ++r) p0[r] = fmaf(p0[r], C2, mnL);
#pragma unroll
    for (int r = 0; r < 16; ++r) p1[r] = fmaf(p1[r], C2, mnL);
#pragma unroll
    for (int r = 0; r < 16; ++r) p0[r] = __builtin_amdgcn_exp2f(p0[r]);
}
__device__ __forceinline__ void finishSM(f32x16& p0, f32x16& p1, float alpha, float& l_reg, bf16x8& pa0, bf16x8& pa1, bf16x8& pa2, bf16x8& pa3) {
#pragma unroll
    for (int r = 0; r < 16; ++r) p1[r] = __builtin_amdgcn_exp2f(p1[r]);
    float ps = 0.f;
#pragma unroll
    for (int r = 0; r < 16; ++r) ps += p0[r];
#pragma unroll
    for (int r = 0; r < 16; ++r) ps += p1[r];
    { auto rr = __builtin_amdgcn_permlane32_swap(__float_as_uint(ps), __float_as_uint(ps), false, false);
      ps = __uint_as_float(rr[0]) + __uint_as_float(rr[1]); }
    l_reg = l_reg * alpha + ps;
    pack_p(p0, p1, pa0, pa1, pa2, pa3);
}
__device__ __forceinline__ float dil_apply(float s, int d) {
    constexpr float INV_SCALE = 11.313708498984761f;
    const unsigned u = (unsigned)d;
    const int cnt = (u <= 128u ? 1 : 0) + (((u & 3u) == 0u && u <= 512u) ? 1 : 0) + (((u & 15u) == 0u && u <= 512u) ? 1 : 0);
    const float b = cnt == 3 ? 1.0986122886681098f * INV_SCALE : (cnt == 2 ? 0.6931471805599453f * INV_SCALE : 0.f);
    return cnt == 0 ? -__builtin_inff() : s + b;
}
__device__ __forceinline__ void sb_tile(f32x16& p0, f32x16& p1, int dq, int hi, float& R) {
    constexpr float C2 = 1.4426950408889634f * 0.08838834764831845f;
    float lk[32];
#pragma unroll
    for (int e = 0; e < 32; ++e) {
        const int r = e & 15; const int c = (r & 3) + 8 * (r >> 2) + (e >= 16 ? 32 : 0);
        const bool valid = (dq - c) >= 1;
        const float z2 = (e < 16 ? p0[r] : p1[r]) * C2;
        const float ex = __builtin_amdgcn_exp2f(-fabsf(z2));
        const float sp = fmaxf(z2, 0.f) + __builtin_amdgcn_logf(1.0f + ex);
        lk[e] = valid ? -sp : 0.f;
        const float ls = valid ? (z2 - sp) : -__builtin_inff();
        if (e < 16) p0[r] = ls; else p1[r] = ls;
    }
    float gs[8];
#pragma unroll
    for (int g = 0; g < 8; ++g) { const float s3 = lk[4 * g + 3], s2 = s3 + lk[4 * g + 2], s1 = s2 + lk[4 * g + 1]; gs[g] = s1 + lk[4 * g];
        lk[4 * g + 3] = 0.f; lk[4 * g + 2] = s3; lk[4 * g + 1] = s2; lk[4 * g] = s1; }
    float run = R;
#pragma unroll
    for (int g = 7; g >= 0; --g) {
        auto rr = __builtin_amdgcn_permlane32_swap(__float_as_uint(gs[g]), __float_as_uint(gs[g]), false, false);
        const float lo = __uint_as_float(rr[0]), hv = __uint_as_float(rr[1]);
        const float base = run + (hi == 0 ? hv : 0.f);
#pragma unroll
        for (int j = 0; j < 4; ++j) lk[4 * g + j] += base;
        run += lo + hv;
    }
    R = run;
#pragma unroll
    for (int r = 0; r < 16; ++r) { p0[r] = __builtin_amdgcn_exp2f(p0[r] + lk[r]); p1[r] = __builtin_amdgcn_exp2f(p1[r] + lk[16 + r]); }
}

struct Blk { const bf16* Q; const bf16* K; const bf16* V; const bf16* K2; const float* kbias; bf16* O; float* lse; int qs, ks, vs, k2s, os, P0, lses; float kmax; };

__device__ __forceinline__ bf16x8 ld8(const bf16* p) { return *reinterpret_cast<const bf16x8*>(p); }

template <int MODE, int ORD>
__device__ __forceinline__ void attn_block(const Blk& c, char* lds) {
    constexpr bool MLA = (MODE == 0), DIL = (MODE == 1), FOX = (MODE == 2), STK = (MODE == 3), DILF = (MODE == 4);
    constexpr int NQ = DIL ? 0 : 8, NQT = MLA ? 12 : 8, Q2OFF = DIL ? OFF_K2 : OFF_Q2, Q2SL = DIL ? 8192 : 4096;
#define BAR_LDS() asm volatile("s_waitcnt lgkmcnt(0)\n\ts_barrier" ::: "memory")
    int tid = threadIdx.x; asm volatile("" : "+v"(tid));
    const int wid = __builtin_amdgcn_readfirstlane(tid >> 6), lane = tid & 63, r32 = lane & 31, hi = lane >> 5;
    const char* q2p = lds + Q2OFF + wid * Q2SL + lane * 16;
    const int j_hi = c.P0 / 64 + 4;
    int j_lo = 0; if (DIL) { j_lo = (c.P0 - 512) / 64; if (j_lo < 0) j_lo = 0; }
    const int NT = j_hi - j_lo;
    const int qlo = c.P0 + wid * 32, qm = qlo + r32 - 4 * hi;
    float* ws = (float*)(lds + OFF_WS) + wid * 64; float* li_l = ws, * al_l = ws + 32;
    const int sr = tid >> 4, sc = (tid & 15) * 8, vst0 = v_st(sr, sc), vst1 = v_st(32 + sr, sc), kws = KSWZ(sr, sc * 2);
    const int k2r = tid >> 3, k2c = (tid & 7) * 8;
    const int vb0 = (int)(uintptr_t)lds + v_rd_base(lane);
#define KBASE(t) ((STK || FOX) ? (j_hi - 1 - (t)) * 64 : (j_lo + (t)) * 64)
    bf16x8 qr[NQ > 0 ? NQ : 1];
#pragma unroll
    for (int d0 = 0; d0 < NQ; ++d0) qr[d0] = ld8(c.Q + (size_t)(wid * 32 + r32) * c.qs + d0 * 16 + hi * 8);
#pragma unroll
    for (int dd = NQ; dd < NQT; ++dd) *(bf16x8*)(lds + Q2OFF + wid * Q2SL + lane * 16 + (dd - NQ) * 1024) = ld8(c.Q + (size_t)(wid * 32 + r32) * c.qs + dd * 16 + hi * 8);
    constexpr bool DS = false;
    struct StSet { bf16x8 k0, k1, v0, v1, k2; };
    StSet stA, stB;
#define SLOAD_S(S, k0_) do { S.v0 = ld8(c.V + (size_t)((k0_) + sr) * c.vs + sc); S.v1 = ld8(c.V + (size_t)((k0_) + 32 + sr) * c.vs + sc); \
                       S.k0 = ld8(c.K + (size_t)((k0_) + sr) * c.ks + sc); S.k1 = ld8(c.K + (size_t)((k0_) + 32 + sr) * c.ks + sc); \
                       if constexpr (MLA) S.k2 = ld8(c.K2 + (size_t)((k0_) + k2r) * c.k2s + k2c); } while (0)
#define SWRITE_S(S, bf) do { *(bf16x8*)(lds + OFF_V + (bf) * SHM_V + vst0) = S.v0; *(bf16x8*)(lds + OFF_V + (bf) * SHM_V + vst1) = S.v1; \
                        *(bf16x8*)(lds + OFF_K + (bf) * SHM_K + kws) = S.k0; *(bf16x8*)(lds + OFF_K + (bf) * SHM_K + kws + 32 * 256) = S.k1; \
                        if constexpr (MLA) *(bf16x8*)(lds + OFF_K2 + (bf) * SHM_K2 + k2r * K2ROW + k2c * 2) = S.k2; } while (0)
#define SLOAD(k0_) SLOAD_S(stA, k0_)
#define SWRITE(bf) SWRITE_S(stA, bf)
    if constexpr (FOX) {
        const int nk = c.P0 + 256;
#pragma unroll
        for (int j = 0; j < 2; ++j) { const int i = tid * 4 + j * 2048;
            if (i < nk) { f32x4 kb_; kb_[0] = __hip_atomic_load(c.kbias + i, __ATOMIC_RELAXED, __HIP_MEMORY_SCOPE_AGENT); kb_[1] = __hip_atomic_load(c.kbias + i + 1, __ATOMIC_RELAXED, __HIP_MEMORY_SCOPE_AGENT);
                          kb_[2] = __hip_atomic_load(c.kbias + i + 2, __ATOMIC_RELAXED, __HIP_MEMORY_SCOPE_AGENT); kb_[3] = __hip_atomic_load(c.kbias + i + 3, __ATOMIC_RELAXED, __HIP_MEMORY_SCOPE_AGENT);
                          *(f32x4*)(lds + OFF_KB + i * 4) = kb_; } }
    }
    if constexpr (FOX) {
        float q2 = 0.f;
#pragma unroll
        for (int d0 = 0; d0 < 8; ++d0)
#pragma unroll
            for (int j = 0; j < 8; ++j) { const float x = __builtin_bit_cast(float, (unsigned)(unsigned short)qr[d0][j] << 16); q2 += x * x; }
        { auto rr = __builtin_amdgcn_permlane32_swap(__float_as_uint(q2), __float_as_uint(q2), false, false); q2 = __uint_as_float(rr[0]) + __uint_as_float(rr[1]); }
#pragma unroll
        for (int o_ = 1; o_ < 32; o_ <<= 1) q2 = fmaxf(q2, __shfl_xor(q2, o_));
        if (lane == 0) ((float*)(lds + OFF_FLG))[8 + wid] = q2;
    }
    SLOAD(KBASE(0)); VM_WAIT(); SWRITE(0);
    BAR_LDS();
    float m_reg = -1e30f, l_reg = 0.f; f32x16 o[4] = {};
    bf16x8 pa0, pa1, pa2, pa3;
#define ADJUST(P0_, P1_, t) do { const int kb_ = KBASE(t); const int dq = qm - kb_; \
        if constexpr (FOX) { const char* bp = lds + OFF_KB + (kb_ + 4 * hi) * 4; \
            _Pragma("unroll") for (int g_ = 0; g_ < 4; ++g_) { const f32x4 b0_ = *(const f32x4*)(bp + 32 * g_), b1_ = *(const f32x4*)(bp + 128 + 32 * g_); \
                _Pragma("unroll") for (int j_ = 0; j_ < 4; ++j_) { P0_[4 * g_ + j_] += b0_[j_]; P1_[4 * g_ + j_] += b1_[j_]; } } } \
        if constexpr (DIL) { const int dlo_ = qlo - kb_ - 63, dhi_ = qlo + 31 - kb_;            \
            const float NEG_ = -__builtin_inff(); \
            if (dlo_ > 512) {                                                                     \
                _Pragma("unroll") for (int r_ = 0; r_ < 16; ++r_) { P0_[r_] = NEG_; P1_[r_] = NEG_; } } \
            else if (dlo_ > 128 && dhi_ <= 512) {                                                 \
                _Pragma("unroll") for (int r_ = 0; r_ < 16; ++r_) { const int c_ = (r_ & 3) + 8 * (r_ >> 2); const int d_ = dq - c_; const bool o4_ = (d_ & 3) == 0, o16_ = (d_ & 15) == 0; \
                    const float b_ = o16_ ? 0.6931471805599453f * 11.313708498984761f : 0.f; P0_[r_] = o4_ ? P0_[r_] + b_ : NEG_; P1_[r_] = o4_ ? P1_[r_] + b_ : NEG_; } } \
            else { \
                _Pragma("unroll") for (int r_ = 0; r_ < 16; ++r_) { const int c_ = (r_ & 3) + 8 * (r_ >> 2); P0_[r_] = dil_apply(P0_[r_], dq - c_); P1_[r_] = dil_apply(P1_[r_], dq - c_ - 32); } } } \
        if constexpr (DILF) { const float NEG_ = -__builtin_inff();                                 \
            _Pragma("unroll") for (int r_ = 0; r_ < 16; ++r_) { const int c_ = (r_ & 3) + 8 * (r_ >> 2); \
                if ((unsigned)(dq - c_ - 33) > 95u) P0_[r_] = NEG_; if ((unsigned)(dq - c_ - 32 - 33) > 95u) P1_[r_] = NEG_; } } \
        if constexpr (MLA || FOX) { if (kb_ + 63 > qlo) { const float NEG_ = -__builtin_inff(); \
            _Pragma("unroll") for (int r_ = 0; r_ < 16; ++r_) { const int c_ = (r_ & 3) + 8 * (r_ >> 2); if (dq - c_ < 0) P0_[r_] = NEG_; if (dq - c_ - 32 < 0) P1_[r_] = NEG_; } } } } while (0)
#define RESC(a) do { if (__any((a) < 1.f)) { if (hi == 0) al_l[r32] = (a); asm volatile("s_waitcnt lgkmcnt(0)" ::: "memory"); \
                     _Pragma("unroll") for (int d_ = 0; d_ < 4; ++d_) _Pragma("unroll") for (int r_ = 0; r_ < 16; ++r_) o[d_][r_] *= al_l[crow(r_, hi)]; } } while (0)
    if constexpr (STK || FOX || DILF) {
        float R = 0.f; f32x16 p0, p1; float uqk = 0.f;
        if constexpr (FOX) { const float* qf = (const float*)(lds + OFF_FLG) + 8; float q2 = qf[0];
#pragma unroll
            for (int w_ = 1; w_ < 8; ++w_) q2 = fmaxf(q2, qf[w_]);
            uqk = sqrtf(q2) * c.kmax * 1.0001f + 1e-3f; }
#define STEP(BUF, t) do { \
        const bool has_next_ = (t) + 1 < NT; \
        if (has_next_) SLOAD(KBASE((t) + 1)); \
          \
        const int kbt_ = KBASE(t); \
        const bool act_ = STK ? (kbt_ < qlo + 31) : (FOX ? (kbt_ <= qlo + 31) : (qlo + 31 - kbt_ >= 33 && qlo - kbt_ - 63 <= 128)); \
        if (act_) { \
            SBAR(); qkt<BUF, MLA, NQ>(p0, p1, lds, r32, hi, qr, q2p); \
            if constexpr (STK) { sb_tile(p0, p1, qm - kbt_, hi, R); pack_p(p0, p1, pa0, pa1, pa2, pa3); } \
            else { ADJUST(p0, p1, (t)); float al_; partialSM<MODE>(p0, p1, m_reg, al_); RESC(al_); finishSM(p0, p1, al_, l_reg, pa0, pa1, pa2, pa3); } \
            SBAR(); pv_tile<BUF>(o, vb0, pa0, pa1, pa2, pa3); } \
        int dn_ = 0; \
        if constexpr (STK) dn_ = __all(R < -135.f) ? 1 : 0; \
        if constexpr (FOX) { const float kbn_ = has_next_ ? *(const float*)(lds + OFF_KB + (kbt_ - 1) * 4) : 0.f; \
               dn_ = __all((uqk + kbn_ - m_reg) * 0.08838834764831845f < -94.f) ? 1 : 0; } \
        if (has_next_) { VM_WAIT(); SWRITE((BUF) ^ 1); } \
        if (lane == 0) flg[wid] = dn_; \
        BAR_LDS(); } while (0)
#define SB_DONE() ((flg[0] & flg[1] & flg[2] & flg[3] & flg[4] & flg[5] & flg[6] & flg[7]) != 0)
        volatile LAS int* flg = (volatile LAS int*)(lds + OFF_FLG);
        for (int t = 0; t < NT; t += 2) {
            STEP(0, t);
            if (SB_DONE()) break;
            if (t + 1 < NT) { STEP(1, t + 1); if (SB_DONE()) break; }
        }
        BAR_LDS();
#undef SB_DONE
#undef STEP
    } else {
        f32x16 pA0, pA1, pB0, pB1; float alA, alB;
        if (NT > 1) { if constexpr (DS) SLOAD_S(stB, KBASE(1)); else SLOAD_S(stA, KBASE(1)); }
        SBAR(); qkt<0, MLA, NQ>(pA0, pA1, lds, r32, hi, qr, q2p);
        ADJUST(pA0, pA1, 0); partialSM<MODE>(pA0, pA1, m_reg, alA);
        if (NT > 1) { if constexpr (DS) { SWRITE_S(stB, 1); SBAR(); if (NT > 2) SLOAD_S(stA, KBASE(2)); if (NT > 3) SLOAD_S(stB, KBASE(3)); }
                      else { SWRITE_S(stA, 1); SBAR(); if (NT > 2) SLOAD_S(stA, KBASE(2)); } }
        BAR_LDS();
#define HALF_STEP(ORD, PX0, PX1, alX, PY0, PY1, alY, t, KB, VB, SB) do { \
        if (ORD == 0) { \
            SBAR(); qkt<KB, MLA, NQ>(PX0, PX1, lds, r32, hi, qr, q2p); SBAR(); \
            finishSM(PY0, PY1, alY, l_reg, pa0, pa1, pa2, pa3); SBAR(); \
            pv_tile<VB>(o, vb0, pa0, pa1, pa2, pa3); SBAR(); ADJUST(PX0, PX1, (t)); partialSM<MODE>(PX0, PX1, m_reg, alX); \
        } else { \
            SBAR(); finishSM(PY0, PY1, alY, l_reg, pa0, pa1, pa2, pa3); SBAR(); \
            qkt<KB, MLA, NQ>(PX0, PX1, lds, r32, hi, qr, q2p); SBAR(); \
            ADJUST(PX0, PX1, (t)); partialSM<MODE>(PX0, PX1, m_reg, alX); SBAR(); pv_tile<VB>(o, vb0, pa0, pa1, pa2, pa3); \
        } \
        BAR_LDS(); \
        if ((t) + 1 < NT) { if constexpr (DS) { if ((SB) == 0) { SWRITE_S(stA, 0); SBAR(); if ((t) + 3 < NT) SLOAD_S(stA, KBASE((t) + 3)); } else { SWRITE_S(stB, 1); SBAR(); if ((t) + 3 < NT) SLOAD_S(stB, KBASE((t) + 3)); } } \
                            else { SWRITE_S(stA, SB); SBAR(); if ((t) + 2 < NT) SLOAD_S(stA, KBASE((t) + 2)); } } \
        RESC(alX); BAR_LDS(); } while (0)
        for (int t = 1; t + 1 < NT; t += 2) {
            HALF_STEP(ORD, pB0, pB1, alB, pA0, pA1, alA, t, 1, 0, 0);
            HALF_STEP(ORD, pA0, pA1, alA, pB0, pB1, alB, t + 1, 0, 1, 1);
        }
        const bool even = (NT & 1) == 0;
        if (even) { SBAR(); qkt<1, MLA, NQ>(pB0, pB1, lds, r32, hi, qr, q2p); SBAR(); }
        finishSM(pA0, pA1, alA, l_reg, pa0, pa1, pa2, pa3); SBAR();
        pv_tile<0>(o, vb0, pa0, pa1, pa2, pa3);
        if (even) { ADJUST(pB0, pB1, NT - 1); partialSM<MODE>(pB0, pB1, m_reg, alB); RESC(alB);
            finishSM(pB0, pB1, alB, l_reg, pa0, pa1, pa2, pa3); SBAR(); pv_tile<1>(o, vb0, pa0, pa1, pa2, pa3); }
#undef HALF_STEP
    }
#undef RESC
    constexpr float SCL = (MODE == 0) ? 0.07216878364870323f : 0.08838834764831845f;
    float rli[16], wf[16];
    if constexpr (STK) {
#pragma unroll
        for (int r = 0; r < 16; ++r) { rli[r] = 1.f; wf[r] = 0.f; }
    } else {
        float sc_ = l_reg > 0.f ? __builtin_amdgcn_rcpf(l_reg) : 0.f, wF_ = 0.f;
        if constexpr (DILF) {
            const float lse_ = l_reg > 0.f ? m_reg * SCL + __logf(l_reg) : -__builtin_inff();
            if (hi == 0) __hip_atomic_store(c.lse + (size_t)(wid * 32 + r32) * c.lses, lse_, __ATOMIC_RELAXED, __HIP_MEMORY_SCOPE_AGENT);
        }
        if constexpr (DIL) {
            const float lseF_ = __hip_atomic_load(c.lse + (size_t)(wid * 32 + r32) * c.lses, __ATOMIC_RELAXED, __HIP_MEMORY_SCOPE_AGENT), lseN_ = m_reg * SCL + __logf(l_reg);
            const float wN_ = __builtin_amdgcn_rcpf(1.0f + __expf(lseF_ - lseN_)); wF_ = 1.0f - wN_; sc_ *= wN_;
        }
        if (hi == 0) { li_l[r32] = sc_; al_l[r32] = wF_; } asm volatile("s_waitcnt lgkmcnt(0)" ::: "memory");
#pragma unroll
        for (int r = 0; r < 16; ++r) { rli[r] = li_l[crow(r, hi)]; wf[r] = DIL ? al_l[crow(r, hi)] : 0.f; }
    }
    bf16* Ow = c.O + (size_t)(wid * 32) * c.os;
    if constexpr (!(STK || FOX || DILF)) BAR_LDS();
    char* stg = lds + wid * 8192;
    if constexpr (DIL) {
#pragma unroll
        for (int i = 0; i < 16; ++i) { const int row = 2 * i + (lane >> 5), c8 = lane & 31;
            const unsigned long long q = __hip_atomic_load((const unsigned long long*)(Ow + (size_t)row * c.os + c8 * 4), __ATOMIC_RELAXED, __HIP_MEMORY_SCOPE_AGENT);
            *(unsigned long long*)(stg + row * 256 + c8 * 8) = q; }
        asm volatile("s_waitcnt lgkmcnt(0)" ::: "memory");
#pragma unroll
        for (int r = 0; r < 16; ++r)
#pragma unroll
            for (int d0 = 0; d0 < 4; ++d0) { const unsigned of = *(const unsigned short*)(stg + crow(r, hi) * 256 + (d0 * 32 + r32) * 2);
                o[d0][r] = o[d0][r] * rli[r] + wf[r] * __builtin_bit_cast(float, of << 16); }
#pragma unroll
        for (int r = 0; r < 16; ++r) rli[r] = 1.f;
        asm volatile("s_waitcnt lgkmcnt(0)" ::: "memory");
    }
    { const bool odd = (r32 & 1) != 0;
#pragma unroll
    for (int r = 0; r < 16; ++r) { const int row = crow(r, hi);
#pragma unroll
        for (int dp = 0; dp < 4; dp += 2) {
            const float va = o[dp][r] * rli[r], vb = o[dp + 1][r] * rli[r];
            const float rcv = __int_as_float(__builtin_amdgcn_update_dpp(0, __float_as_int(odd ? va : vb), 0xB1, 0xF, 0xF, true));
            const unsigned pk = cvtpk(odd ? rcv : va, odd ? vb : rcv);
            *(unsigned*)(stg + row * 256 + (odd ? (dp + 1) * 32 + r32 - 1 : dp * 32 + r32) * 2) = pk; } } }
    asm volatile("s_waitcnt lgkmcnt(0)" ::: "memory");
#pragma unroll
    for (int i = 0; i < 8; ++i) { const int row = 4 * i + (lane >> 4); const v4u q = *(const v4u*)(stg + row * 256 + (lane & 15) * 16);
        st16_wt(Ow + (size_t)row * c.os + (lane & 15) * 8, q); }
    BAR_LDS();
#undef ADJUST
#undef BAR_LDS
#undef KBASE
#undef SLOAD
#undef SWRITE
#undef SLOAD_S
#undef SWRITE_S
}
#undef KSWZ
#undef SBAR
}

#define XB_TMO      128
#define XB_XCNT(j)  (256  + 64 * (j))
#define XB_XSUB(j)  (1280 + 64 * (j))
#define XB_XGEN(j)  (2304 + 64 * (j))
#define XB_TOP      3328
#define XB_TOPGEN   3392
#define XCD_BAR_WORDS 3456
#define XB_SPIN_CAP (1u << 18)
__device__ __forceinline__ unsigned xb_ld(unsigned* p)              { return __hip_atomic_load(p, __ATOMIC_RELAXED, __HIP_MEMORY_SCOPE_AGENT); }
__device__ __forceinline__ unsigned xb_add(unsigned* p, unsigned v) { return __hip_atomic_fetch_add(p, v, __ATOMIC_RELAXED, __HIP_MEMORY_SCOPE_AGENT); }
__device__ __forceinline__ unsigned xb_xcc_id() { return (unsigned)__builtin_amdgcn_s_getreg((3 << 11) | 20) & 0xFu; }
#define XB_SPIN(cond, bar) do { unsigned _sp = 0; while (cond) { __builtin_amdgcn_s_sleep(1); \
    if ((++_sp & 255u) == 0u) { if (xb_ld(&(bar)[XB_TMO])) break; if (_sp > XB_SPIN_CAP) { atomicAdd(&(bar)[XB_TMO], 1u); break; } } } } while (0)
struct XcdBarrier { unsigned* bar; unsigned x; volatile LAS unsigned* st; };
__device__ __forceinline__ XcdBarrier xcd_barrier_post(unsigned* bar, volatile LAS unsigned* st) {
    XcdBarrier b; b.bar = bar; b.x = xb_xcc_id(); b.st = st;
    if (threadIdx.x == 0) (void)xb_add(&bar[XB_XCNT(b.x)], 1u);
    return b;
}
__device__ __forceinline__ void xcd_barrier_complete(unsigned* bar, unsigned x, unsigned& nloc, unsigned& nx) {
    const unsigned G = gridDim.x * gridDim.y * gridDim.z;
    unsigned sum, cnt, mine, sp = 0u;
    for (;;) {
        sum = 0u; cnt = 0u; mine = 0u;
#pragma unroll
        for (unsigned j = 0; j < 16; ++j) { const unsigned c = xb_ld(&bar[XB_XCNT(j)]); sum += c; cnt += (c > 0u) ? 1u : 0u; mine = (j == x) ? c : mine; }
        if (sum == G) break;
        __builtin_amdgcn_s_sleep(1);
        if ((++sp & 255u) == 0u) { if (xb_ld(&bar[XB_TMO])) break; if (sp > XB_SPIN_CAP) { atomicAdd(&bar[XB_TMO], 1u); break; } }
    }
    nloc = mine > 0u ? mine : 1u; nx = cnt > 0u ? cnt : 1u;
}
__device__ __forceinline__ void xcd_barrier(const XcdBarrier& b) {
    asm volatile("s_waitcnt vmcnt(0)" ::: "memory");
    __syncthreads();
    if (threadIdx.x == 0) {
        size_t zb_ = 0; asm volatile("" : "+s"(zb_));
        unsigned* bar = b.bar + zb_;
        __builtin_amdgcn_s_waitcnt(0);
        unsigned nloc = b.st[0], nx = b.st[1];
        if (nloc == 0u) { xcd_barrier_complete(bar, b.x, nloc, nx); b.st[0] = nloc; b.st[1] = nx; }
        const unsigned old = xb_add(&bar[XB_XSUB(b.x)], 1u);
        const unsigned gen = old / nloc;
        if (old + 1u == (gen + 1u) * nloc) {
            __builtin_amdgcn_fence(__ATOMIC_RELEASE, "agent");
            asm volatile("s_waitcnt vmcnt(0)" ::: "memory");
            const unsigned og = xb_add(&bar[XB_TOP], 1u);
            const unsigned tg = og / nx;
            if (og + 1u == (tg + 1u) * nx) xb_add(&bar[XB_TOPGEN], 1u);
            else XB_SPIN(xb_ld(&bar[XB_TOPGEN]) == tg, bar);
            __builtin_amdgcn_fence(__ATOMIC_ACQUIRE, "agent");
            xb_add(&bar[XB_XGEN(b.x)], 1u);
            asm volatile("s_waitcnt vmcnt(0)" ::: "memory");
        } else {
            XB_SPIN(xb_ld(&bar[XB_XGEN(b.x)]) == gen, bar);
            __builtin_amdgcn_fence(__ATOMIC_ACQUIRE, "agent");
            asm volatile("s_waitcnt vmcnt(0)" ::: "memory");
        }
    }
    __syncthreads();
}

struct Args {
    const float* in[15]; float* out; unsigned char* ws;
    double invf128[64]; double invf64[32];
    int ph_lo, ph_hi;
};
struct Frame {
    LAS unsigned char* lds; volatile LAS unsigned* MISC; unsigned* ctl;
    int tid, lane, wave, vcu, G;
};
__device__ __forceinline__ float wave_sum(float v) {
#pragma unroll
    for (int o = 1; o < 64; o <<= 1) v += __shfl_xor(v, o);
    return v;
}
__device__ __forceinline__ void sincos_d(double a, float& c, float& s) {
    const double TWO_PI = 6.283185307179586476925286766559, INV_TWO_PI = 0.15915494309189533576888376337251;
    const double k = __builtin_rint(a * INV_TWO_PI); double r = a - k * TWO_PI;
    const double r2 = r * r;
    double sv = 0.0, cv = 0.0;
    double ts = 1.0, tc = 1.0; sv = 1.0; cv = 1.0;
#pragma unroll
    for (int n = 1; n <= 14; ++n) { tc = -tc * r2 * (1.0 / (double)((2 * n - 1) * (2 * n))); ts = -ts * r2 * (1.0 / (double)((2 * n) * (2 * n + 1))); cv += tc; sv += ts; }
    c = (float)cv; s = (float)(sv * r);
}
__device__ __forceinline__ void p_tables(const Frame& F, const Args& a, unsigned char* ws) {
    f32x2* cs128 = (f32x2*)(ws + WS_CS128); f32x2* cs64 = (f32x2*)(ws + WS_CS64);
    const int gt = F.vcu * 512 + F.tid, NT_ = F.G * 512;
    for (int i = gt; i < SEQ * 64; i += NT_) { const int pos = i >> 6, f = i & 63; float c, s; sincos_d((double)(float)((float)pos * (float)a.invf128[f]), c, s); cs128[i] = (f32x2){c, s}; }
    for (int i = gt; i < SEQ * 32; i += NT_) { const int pos = i >> 5, f = i & 31; float c, s; sincos_d((double)(float)((float)pos * (float)a.invf64[f]), c, s); cs64[i] = (f32x2){c, s}; }
}
template <class RMap>
__device__ __forceinline__ void cvt_item(const float* W, int N, bf16* WT, int ldk, const float* gain, const RMap& rmap, LAS float* scr, int item, int lane) {
    const int nblk = (N + 31) / 32, kb = item / nblk, nb = item % nblk, k0 = 64 * kb, n0 = 32 * nb;
    const int nn = n0 + (lane & 31); const bool inb = nn < N;
    const float* src = W + (size_t)(k0 + (lane >> 5)) * N + (inb ? nn : 0);
    float v[32];
#pragma unroll
    for (int i = 0; i < 32; ++i) v[i] = src[(size_t)(2 * i) * N];
    const int c = lane & 7;
    f32x4 g0 = {1.f, 1.f, 1.f, 1.f}, g1 = g0;
    if (gain) { g0 = *(const f32x4*)(gain + k0 + 8 * c); g1 = *(const f32x4*)(gain + k0 + 8 * c + 4); }
#pragma unroll
    for (int i = 0; i < 32; ++i) scr[(2 * i + (lane >> 5)) * 33 + (lane & 31)] = inb ? v[i] : 0.f;
    LDS_WAIT(); asm volatile("" ::: "memory");
#pragma unroll
    for (int j = 0; j < 4; ++j) { const int nl = (lane >> 3) + 8 * j; const LAS float* s = scr + (8 * c) * 33 + nl;
        v4u o; o.x = pk2(s[0 * 33] * g0[0], s[1 * 33] * g0[1]); o.y = pk2(s[2 * 33] * g0[2], s[3 * 33] * g0[3]); o.z = pk2(s[4 * 33] * g1[0], s[5 * 33] * g1[1]); o.w = pk2(s[6 * 33] * g1[2], s[7 * 33] * g1[3]);
        if (n0 + nl < N) *(v4u*)(WT + (size_t)rmap(n0 + nl) * ldk + k0 + 8 * c) = o; }
    LDS_WAIT(); asm volatile("" ::: "memory");
}
struct MapIn { __device__ __forceinline__ int operator()(int n) const {
    if (n < 1024) return n;
    if (n < 1088) { const int i = n - 1024; return PC_KROPE + (i < 32 ? 2 * i : 2 * (i - 32) + 1); }
    if (n < 2112) { const int j = n - 1088, grp = j >> 9, r = j & 511, h = r >> 7, i = r & 127; return PC_QB + grp * 512 + h * 128 + (i < 64 ? 2 * i : 2 * (i - 64) + 1); }
    if (n < 2624) return PC_VB + (n - 2112);
    if (n < 4160) return PC_QC + (n - 2624);
    if (n < 4164) return PC_FC + (n - 4160);
    return PC_QD + (n - 4164); } };
struct MapUq { __device__ __forceinline__ int operator()(int n) const { const int h = n / 192, e = n % 192; if (e < 128) return n; const int j = e - 128; return h * 192 + 128 + (j < 32 ? 2 * j : 2 * (j - 32) + 1); } };
struct MapUkv { __device__ __forceinline__ int operator()(int n) const { const int h = n >> 8, e = n & 255; return 768 + (e < 128 ? h * 128 + e : 512 + h * 128 + (e - 128)); } };
struct MapId { __device__ __forceinline__ int operator()(int n) const { return n; } };
struct MapGate { int up; __device__ __forceinline__ int operator()(int n) const { return 256 * (n >> 7) + (n & 127) + up * 128; } };

__device__ __forceinline__ void p_convert(const Frame& F0, const Args& a, int l, bf16* WB, int max_units = 1 << 30) {
    Frame F = F0; { int t_ = threadIdx.x; asm volatile("" : "+v"(t_)); F.tid = t_; F.lane = t_ & 63; F.wave = __builtin_amdgcn_readfirstlane(t_ >> 6); }
    LAS float* scr = (LAS float*)(F.lds + F.wave * 16384);
    int kz = 0; asm volatile("" : "+s"(kz));
    const float* w_in = a.in[2 + kz] + (size_t)l * DM * IN_W;   const float* g_attn = a.in[1 + kz] + (size_t)l * DM;
    const float* w_uq = a.in[4 + kz] + (size_t)l * 512 * 768;    const float* g_q = a.in[3 + kz] + (size_t)l * 512;
    const float* w_ukv = a.in[6 + kz] + (size_t)l * 512 * 1024;  const float* g_kv = a.in[5 + kz] + (size_t)l * 512;
    const float* w_out = a.in[9 + kz] + (size_t)l * DM * DM;     const float* g_grp = a.in[8 + kz] + (size_t)l * DM;
    const float* w_gate = a.in[11 + kz] + (size_t)l * DM * FFN;  const float* w_up = a.in[12 + kz] + (size_t)l * DM * FFN; const float* g_ffn = a.in[10 + kz] + (size_t)l * DM;
    const float* w_down = a.in[13 + kz] + (size_t)l * FFN * DM;
    constexpr int I_IN = (DM / 64) * ((IN_W + 31) / 32), I_UQ = (512 / 64) * (768 / 32), I_UKV = (512 / 64) * (1024 / 32), I_OUT = (DM / 64) * (DM / 32),
                  I_G = (DM / 64) * (FFN / 32), I_DN = (FFN / 64) * (DM / 32);
    constexpr int NITEMS = I_IN + I_UQ + I_UKV + I_OUT + 2 * I_G + I_DN, NUNITS = (NITEMS + 63) / 64;
    unsigned* head = F.ctl + CW_CVTQ + l * 64;
    for (int done_ = 0; done_ < max_units; ++done_) {
        if (F.tid == 0) F.MISC[17] = __hip_atomic_fetch_add(head, 1u, RLX_AGENT);
        __syncthreads();
        const unsigned unit = (unsigned)__builtin_amdgcn_readfirstlane((int)F.MISC[17]);
        __syncthreads();
        if (unit > (unsigned)NUNITS) break;
        if (unit == (unsigned)NUNITS) {
            v4u* z = (v4u*)(WB + WB_IN + (size_t)PC_PAD0 * DM); const int n16 = (PC_QB - PC_PAD0) * DM / 8;
            unsigned zz = 0u; asm volatile("" : "+v"(zz));
            for (int i = F.tid; i < n16; i += 512) z[i] = (v4u){zz, zz, zz, zz};
            continue;
        }
        for (int j = 0; j < 8; ++j) {
            int r = (int)unit * 64 + F.wave * 8 + j; if (r >= NITEMS) break;
            if (r < I_IN) { cvt_item(w_in, IN_W, WB + WB_IN, DM, g_attn, MapIn{}, scr, r, F.lane); continue; } r -= I_IN;
            if (r < I_UQ) { cvt_item(w_uq, 768, WB + WB_UP, 512, g_q, MapUq{}, scr, r, F.lane); continue; } r -= I_UQ;
            if (r < I_UKV) { cvt_item(w_ukv, 1024, WB + WB_UP, 512, g_kv, MapUkv{}, scr, r, F.lane); continue; } r -= I_UKV;
            if (r < I_OUT) { cvt_item(w_out, DM, WB + WB_OUT, DM, g_grp, MapId{}, scr, r, F.lane); continue; } r -= I_OUT;
            if (r < I_G) { cvt_item(w_gate, FFN, WB + WB_GU, DM, g_ffn, MapGate{0}, scr, r, F.lane); continue; } r -= I_G;
            if (r < I_G) { cvt_item(w_up, FFN, WB + WB_GU, DM, g_ffn, MapGate{1}, scr, r, F.lane); continue; } r -= I_G;
            cvt_item(w_down, DM, WB + WB_DN, FFN, (const float*)nullptr, MapId{}, scr, r, F.lane);
        }
    }
}
__device__ __forceinline__ void p_rownorm(const Frame& F, const float* x, bf16* xb, unsigned char* xl, u64* ss) {
    const int gw = F.vcu * 8 + F.wave, NGW = F.G * 8;
    f32x4 v[8];
    if (gw < M) { const f32x4* xr = (const f32x4*)(x + (size_t)gw * DM) + F.lane;
#pragma unroll
        for (int j = 0; j < 8; ++j) v[j] = xr[64 * j]; }
    for (int m = gw; m < M; m += NGW) {
        const int mn = m + NGW; f32x4 nv[8];
#pragma unroll
        for (int j = 0; j < 8; ++j) nv[j] = v[j];
        if (mn < M) { const f32x4* xn = (const f32x4*)(x + (size_t)mn * DM) + F.lane;
#pragma unroll
            for (int j = 0; j < 8; ++j) nv[j] = xn[64 * j]; }
        float s = 0.f;
#pragma unroll
        for (int j = 0; j < 8; ++j) s += (v[j].x * v[j].x + v[j].y * v[j].y) + (v[j].z * v[j].z + v[j].w * v[j].w);
        s = wave_sum(s);
        if (F.lane == 0) ss[m] = (u64)(s * SS_FIX + 0.5f);
        v2u* o8 = (v2u*)(xb + (size_t)m * DM) + F.lane; unsigned char* o4 = xl + (size_t)m * DM;
#pragma unroll
        for (int j = 0; j < 8; ++j) { o8[64 * j] = (v2u){pg8::cvt_pk_bf16(v[j].x, v[j].y), pg8::cvt_pk_bf16(v[j].z, v[j].w)}; } (void)o4;
#pragma unroll
        for (int j = 0; j < 8; ++j) v[j] = nv[j];
    }
}
__device__ __forceinline__ void p_final(const Frame& F, const bf16* xb, const unsigned char* xl, float* out, const float* gain) {
    const int gw = F.vcu * 8 + F.wave, NGW = F.G * 8;
    f32x4 g[4][2];
#pragma unroll
    for (int j = 0; j < 4; ++j) { const int c8 = (64 * j + F.lane) * 2; g[j][0] = ((const f32x4*)gain)[c8]; g[j][1] = ((const f32x4*)gain)[c8 + 1]; }
    v4u q[4]; v2u e[4];
    if (gw < M) { const v4u* xr = (const v4u*)(xb + (size_t)gw * DM) + F.lane; const unsigned char* er = xl + (size_t)gw * DM;
#pragma unroll
        for (int j = 0; j < 4; ++j) { q[j] = xr[64 * j]; e[j] = (v2u){0u, 0u}; } (void)er; }
    for (int m = gw; m < M; m += NGW) {
        const int mn = m + NGW; v4u nq[4]; v2u ne[4];
#pragma unroll
        for (int j = 0; j < 4; ++j) { nq[j] = q[j]; ne[j] = e[j]; }
        if (mn < M) { const v4u* xr = (const v4u*)(xb + (size_t)mn * DM) + F.lane; const unsigned char* er = xl + (size_t)mn * DM;
#pragma unroll
            for (int j = 0; j < 4; ++j) { nq[j] = xr[64 * j]; } (void)er; }
        float v[4][8]; float s = 0.f;
#pragma unroll
        for (int j = 0; j < 4; ++j) { const unsigned qh[4] = {q[j].x, q[j].y, q[j].z, q[j].w}; const unsigned ql[2] = {e[j].x, e[j].y};
            v[j][0] = res_join<0>(qh[0], ql[0]); v[j][1] = res_join<1>(qh[0], ql[0]); v[j][2] = res_join<2>(qh[1], ql[0]); v[j][3] = res_join<3>(qh[1], ql[0]);
            v[j][4] = res_join<0>(qh[2], ql[1]); v[j][5] = res_join<1>(qh[2], ql[1]); v[j][6] = res_join<2>(qh[3], ql[1]); v[j][7] = res_join<3>(qh[3], ql[1]);
#pragma unroll
            for (int k = 0; k < 8; ++k) s += v[j][k] * v[j][k]; }
        s = wave_sum(s);
        const float rs = 1.0f / sqrtf(s * (1.0f / DM) + EPS);
        f32x4* orow = (f32x4*)(out + (size_t)m * DM);
#pragma unroll
        for (int j = 0; j < 4; ++j) { const int c8 = (64 * j + F.lane) * 2;
            orow[c8] = (f32x4){v[j][0], v[j][1], v[j][2], v[j][3]} * rs * g[j][0];
            orow[c8 + 1] = (f32x4){v[j][4], v[j][5], v[j][6], v[j][7]} * rs * g[j][1]; }
#pragma unroll
        for (int j = 0; j < 4; ++j) { q[j] = nq[j]; e[j] = ne[j]; }
    }
}
__device__ __forceinline__ void p_foxscan(const Frame& F, const Args& a, int l, unsigned char* ws, int bh, int part) {
    const int b = bh >> 2, h = bh & 3; const float fb = a.in[7][l * 4 + h];
    volatile LAS float* wt = (volatile LAS float*)(F.MISC + 32);
    if (part == 0) {
    const float* fc = (const float*)(ws + WS_FC) + (size_t)b * SEQ * 4 + h; float* kb = (float*)(ws + WS_KBIAS) + (size_t)bh * SEQ;
    float v[8]; float tot = 0.f;
#pragma unroll
    for (int i = 0; i < 8; ++i) { const float f = fc[(size_t)(F.tid * 8 + i) * 4] + fb; tot += fminf(f, 0.f) - __logf(1.0f + __expf(-fabsf(f))); v[i] = tot; }
    float inc = tot;
#pragma unroll
    for (int o = 1; o < 64; o <<= 1) { const float t = __shfl_up(inc, o); if (F.lane >= o) inc += t; }
    if (F.lane == 63) wt[F.wave] = inc;
    __syncthreads();
    float off = inc - tot;
    for (int w = 0; w < 8; ++w) if (w < F.wave) off += wt[w];
#pragma unroll
    for (int i = 0; i < 8; ++i) v[i] = -(v[i] + off) * 11.313708498984761f;
    st16_wt(kb + F.tid * 8, __builtin_bit_cast(v4u, (f32x4){v[0], v[1], v[2], v[3]})); st16_wt(kb + F.tid * 8 + 4, __builtin_bit_cast(v4u, (f32x4){v[4], v[5], v[6], v[7]}));
    }
    const bf16* kp = (const bf16*)(ws + WS_PROJ) + (size_t)b * SEQ * PW + PC_KC + h * 128 + (F.lane & 15) * 8;
    float kmx = 0.f;
    for (int i0 = part * (SEQ / 128); i0 < (part + 1) * (SEQ / 128); i0 += 8) {
        v4u wv[8];
#pragma unroll
        for (int k = 0; k < 8; ++k) wv[k] = *(const v4u*)(kp + (size_t)((i0 + k) * 32 + F.wave * 4 + (F.lane >> 4)) * PW);
#pragma unroll
        for (int k = 0; k < 8; ++k) { const v4u w = wv[k];
            float s2 = bflo(w.x) * bflo(w.x) + bfhi(w.x) * bfhi(w.x) + bflo(w.y) * bflo(w.y) + bfhi(w.y) * bfhi(w.y) + bflo(w.z) * bflo(w.z) + bfhi(w.z) * bfhi(w.z) + bflo(w.w) * bflo(w.w) + bfhi(w.w) * bfhi(w.w);
#pragma unroll
            for (int o = 1; o < 16; o <<= 1) s2 += __shfl_xor(s2, o);
            kmx = fmaxf(kmx, s2); } }
#pragma unroll
    for (int o = 16; o < 64; o <<= 1) kmx = fmaxf(kmx, __shfl_xor(kmx, o));
    if (F.lane == 0) wt[8 + F.wave] = kmx;
    VM_WAIT();
    __syncthreads();
    if (F.tid == 0) { float m = wt[8]; for (int w = 1; w < 8; ++w) m = fmaxf(m, wt[8 + w]); __hip_atomic_fetch_max(F.ctl + CW_KMAX + l * 64 + bh, __float_as_uint(m), RLX_AGENT);
                      VM_WAIT(); __hip_atomic_fetch_add(F.ctl + CW_SCN + l * 64 + bh, 1u, RLX_AGENT); }
    __syncthreads();
}
template <int MODE>
__device__ __forceinline__ void p_attn_mode(const Frame& F, unsigned char* ws, int l, char* ldsg, const Args& args) {
    const bf16* proj = (const bf16*)(ws + WS_PROJ); const bf16* mla = (const bf16*)(ws + WS_MLA); bf16* y = (bf16*)(ws + WS_Y);
    unsigned* heads = F.ctl + CW_ATTQ + (l * 5 + MODE) * 8 * 64;
    unsigned qx = xb_xcc_id() & 7u, qtried = 0u;
#define ATT_DEQUEUE() do { unsigned it_ = 0xffffffffu; while (qtried < 8u) { const unsigned i_ = __hip_atomic_fetch_add(heads + qx * 64, 1u, RLX_AGENT); \
            if (i_ < 64u) { it_ = qx * 64u + i_; break; } qx = (qx + 1u) & 7u; ++qtried; } F.MISC[16] = it_; } while (0)
    if (F.tid == 0) ATT_DEQUEUE();
    __syncthreads();
    unsigned item = (unsigned)__builtin_amdgcn_readfirstlane((int)F.MISC[16]);
    __syncthreads();
    while (item < 512u) {
        const int qb_raw = (int)((item & 63u) >> 2), qb = 15 - qb_raw, bh = (int)((item >> 6) * 4u + (item & 3u)), b = bh >> 2, h = bh & 3;
        att::Blk c; c.P0 = qb * 256; c.kbias = nullptr; c.K2 = nullptr; c.k2s = 0; c.lse = nullptr; c.lses = 1;
        const size_t tok0 = (size_t)b * SEQ;
        if (MODE == 1) {
            if (F.tid == 0) { unsigned sp_ = 0; while (__hip_atomic_load(F.ctl + CW_FDN + l * 64 + bh, RLX_AGENT) < 16u) { __builtin_amdgcn_s_sleep(4); if (++sp_ > (1u << 22)) break; } }
            __syncthreads();
        }
        if (MODE == 2) {
            if (F.tid == 0) { unsigned sp_ = 0; while (__hip_atomic_load(F.ctl + CW_SCN + l * 64 + bh, RLX_AGENT) < 4u) { __builtin_amdgcn_s_sleep(4); if (++sp_ > (1u << 22)) break; } }
            __syncthreads();
        }
        if (MODE == 0) { c.Q = mla + (tok0 + c.P0) * UPW + h * 192; c.qs = UPW; c.K = mla + tok0 * UPW + 768 + h * 128; c.ks = UPW; c.V = mla + tok0 * UPW + 1280 + h * 128; c.vs = UPW;
                         c.K2 = proj + tok0 * PW + PC_KROPE; c.k2s = PW; }
        else if (MODE == 4) { const int cls = qb_raw;
               c.P0 = 0; c.Q = proj + (tok0 + cls) * PW + PC_QB + h * 128; c.K = proj + (tok0 + cls) * PW + PC_KB + h * 128; c.V = proj + (tok0 + cls) * PW + PC_VB + h * 128; c.qs = c.ks = c.vs = 16 * PW;
               c.lse = (float*)(ws + WS_LSE) + (size_t)bh * SEQ + cls; c.lses = 16; }
        else { const int qc = MODE == 1 ? PC_QB : (MODE == 2 ? PC_QC : PC_QD);
               c.Q = proj + (tok0 + c.P0) * PW + qc + h * 128; c.K = proj + tok0 * PW + qc + 512 + h * 128; c.V = proj + tok0 * PW + qc + 1024 + h * 128; c.qs = c.ks = c.vs = PW;
               if (MODE == 1) { c.lse = (float*)(ws + WS_LSE) + (size_t)bh * SEQ + c.P0; c.lses = 1; } }
        c.kmax = 0.f; if (MODE == 2) { c.kbias = (const float*)(ws + WS_KBIAS) + (size_t)bh * SEQ; c.kmax = sqrtf(__uint_as_float(__hip_atomic_load(F.ctl + CW_KMAX + l * 64 + bh, RLX_AGENT))); }
        c.O = y + (tok0 + c.P0) * DM + MODE * 512 + h * 128; c.os = DM;
        if (MODE == 4) { c.O = y + (tok0 + qb_raw) * DM + 512 + h * 128; c.os = 16 * DM; }
        if (MODE >= 3 || F.wave < 4) att::attn_block<MODE, 0>(c, ldsg); else att::attn_block<MODE, 1>(c, ldsg);
        asm volatile("s_waitcnt vmcnt(0)" ::: "memory");
        __syncthreads();
        if (F.tid == 0) { const unsigned a_ = (MODE == 4) ? (__hip_atomic_fetch_add(F.ctl + CW_FDN + l * 64 + bh, 1u, RLX_AGENT), 0u) : __hip_atomic_fetch_add(F.ctl + CW_GNC + ((l * 128 + b * 16 + qb) * 4 + MODE), 1u, RLX_AGENT);
                          F.MISC[18] = a_; ATT_DEQUEUE(); }
        __syncthreads();
        const unsigned arrived = (unsigned)__builtin_amdgcn_readfirstlane((int)F.MISC[18]);
        item = (unsigned)__builtin_amdgcn_readfirstlane((int)F.MISC[16]);
        if (arrived == 3u) {
            __builtin_amdgcn_fence(__ATOMIC_ACQUIRE, "agent"); asm volatile("s_waitcnt vmcnt(0)" ::: "memory");
            bf16* yb = y + (tok0 + c.P0) * DM + MODE * 512 + F.lane * 8;
            for (int r0 = F.wave * 32; r0 < F.wave * 32 + 32; r0 += 8) {
                v4u q[8];
#pragma unroll
                for (int j = 0; j < 8; ++j) q[j] = *(const v4u*)(yb + (size_t)(r0 + j) * DM);
#pragma unroll
                for (int j = 0; j < 8; ++j) { const unsigned w[4] = {q[j].x, q[j].y, q[j].z, q[j].w}; float ssq = 0.f;
#pragma unroll
                    for (int k = 0; k < 4; ++k) { const float lo = bflo(w[k]), hv = bfhi(w[k]); ssq += lo * lo + hv * hv; }
                    ssq = wave_sum(ssq);
                    const float rs = 1.0f / sqrtf(ssq * (1.0f / 512.0f) + EPS); unsigned o[4];
#pragma unroll
                    for (int k = 0; k < 4; ++k) o[k] = pk2(bflo(w[k]) * rs, bfhi(w[k]) * rs);
                    *(v4u*)(yb + (size_t)(r0 + j) * DM) = (v4u){o[0], o[1], o[2], o[3]}; }
            }
        }
        __syncthreads();
        if (MODE == 0 && l + 1 < DEPTH) { p_convert(F, args, l + 1, (bf16*)(ws + (((l + 1) & 1) ? WS_WB1 : WS_WB)), 1); __syncthreads(); }
    }
#undef ATT_DEQUEUE
}

constexpr int N_PHASES = 42;
__global__ void __launch_bounds__(512, 2) fwd_kernel(Args args) {
    extern __shared__ __attribute__((aligned(16))) unsigned char lds[];
    Frame F;
    F.lds = (LAS unsigned char*)lds; F.MISC = (volatile LAS unsigned*)(F.lds + MISC_OFF);
    F.tid = threadIdx.x; F.lane = F.tid & 63; F.wave = __builtin_amdgcn_readfirstlane(F.tid >> 6);
    F.G = gridDim.x; { const int bx = blockIdx.x; F.vcu = (F.G % 8 == 0) ? (bx % 8) * (F.G / 8) + bx / 8 : bx; }
    F.ctl = (unsigned*)(args.ws + WS_CTL);
    for (int u = F.tid; u < (LDS_BYTES - LDSCTL_OFF) / 4; u += 512) ((LAS unsigned*)(F.lds + LDSCTL_OFF))[u] = 0u;
    __syncthreads();
    XcdBarrier bar; bar.bar = F.ctl + CW_BAR; bar.x = 0; bar.st = nullptr;
    if (!MK_PER_PHASE_LAUNCH) bar = xcd_barrier_post(F.ctl + CW_BAR, F.MISC + 8);
    const int lo = args.ph_lo, hi = args.ph_hi;
#define IN(k) (lo <= (k) && (k) < hi)
#define SEAM(k) do { if (!MK_PER_PHASE_LAUNCH && (k) + 1 < hi) xcd_barrier(bar); } while (0)
#define LAUNDER_S(p) asm volatile("" : "+s"(p))
#define PHASE_FRAME_L(l_) Frame Fp = F; { int t_ = threadIdx.x; asm volatile("" : "+v"(t_)); Fp.tid = t_; Fp.lane = t_ & 63; Fp.wave = __builtin_amdgcn_readfirstlane(t_ >> 6); } \
        size_t zoff_ = 0; LAUNDER_S(zoff_); unsigned char* ws = args.ws + zoff_; float* OUT = args.out + zoff_; \
        bf16* WB = (bf16*)(ws + (((l_) & 1) ? WS_WB1 : WS_WB)); bf16* XB = (bf16*)(ws + WS_XB); unsigned char* XL = ws + WS_XL; bf16* PROJ = (bf16*)(ws + WS_PROJ); bf16* MLA = (bf16*)(ws + WS_MLA); \
        bf16* Y = (bf16*)(ws + WS_Y); u64* SS = (u64*)(ws + WS_SS); const f32x2* CS128 = (const f32x2*)(ws + WS_CS128); const f32x2* CS64 = (const f32x2*)(ws + WS_CS64); \
        (void)WB; (void)XB; (void)XL; (void)PROJ; (void)MLA; (void)Y; (void)SS; (void)CS128; (void)CS64; (void)OUT; (void)Fp
#define PHASE_FRAME() PHASE_FRAME_L(l)

    if (IN(0)) { PHASE_FRAME_L(0); p_tables(Fp, args, ws); p_convert(Fp, args, 0, WB); p_rownorm(Fp, args.in[0], XB, XL, SS); SEAM(0); }
    for (int l = 0; l < DEPTH; ++l) {
        const int p0 = 1 + 10 * l;
        if (IN(p0 + 1)) { PHASE_FRAME();
            pg8::Gemm g{(const pg8::bf16_t*)XB, (const pg8::bf16_t*)(WB + WB_IN), M, PW, DM, DM, 1 << 30, 0};
            pg8::StaticOrder S; S.init(M, PW, F.G, (int)blockIdx.x);
            EpiProj E{PROJ, SS + (size_t)(2 * l) * M, CS128, CS64, SS + (size_t)(9 + 2 * l) * M, SS + (size_t)(10 + 2 * l) * M, (float*)(ws + WS_FC), Fp.ctl + CW_LAT + l * 256};
            pg8::gemm_phase<EpiProj, true>(F.lds, g, S, E);
        }
        if (IN(p0 + 3)) { PHASE_FRAME();
            pg8::Gemm g{(const pg8::bf16_t*)PROJ, (const pg8::bf16_t*)(WB + WB_UP), M, UPW, 512, PW, 3, 512};
            pg8::UpOrder S; S.G = F.G; S.c = (int)blockIdx.x;
            if (Fp.wave == 0) { pg8::Unit u_; if (S.next(Fp.lane, u_)) { const unsigned* cp_ = Fp.ctl + CW_LAT + l * 256 + u_.pm * 2 + (u_.pn >= 3 ? 1 : 0); unsigned sp_ = 0;
                                    while (__hip_atomic_load(cp_, RLX_AGENT) < 16u) { __builtin_amdgcn_s_sleep(4); if (++sp_ > (1u << 22)) break; } }
                                __builtin_amdgcn_fence(__ATOMIC_ACQUIRE, "agent"); asm volatile("s_waitcnt vmcnt(0)" ::: "memory"); }
            __syncthreads();
            EpiUp E{MLA, SS + (size_t)(9 + 2 * l) * M, SS + (size_t)(10 + 2 * l) * M, CS64};
            pg8::gemm_phase<EpiUp, true>(F.lds, g, S, E);
            SEAM(p0 + 3);
        }
        if (IN(p0 + 4)) {
            { PHASE_FRAME(); for (int task = (int)gridDim.x - 1 - (int)blockIdx.x; task < 128; task += (int)gridDim.x) p_foxscan(Fp, args, l, ws, task & 31, task >> 5); }
            { PHASE_FRAME(); p_attn_mode<4>(Fp, ws, l, (char*)lds, args); }
            { PHASE_FRAME(); p_attn_mode<0>(Fp, ws, l, (char*)lds, args); }
            { PHASE_FRAME(); p_attn_mode<2>(Fp, ws, l, (char*)lds, args); }
            { PHASE_FRAME(); p_attn_mode<1>(Fp, ws, l, (char*)lds, args); }
            { PHASE_FRAME(); p_attn_mode<3>(Fp, ws, l, (char*)lds, args); }
            if (l + 1 < DEPTH) { PHASE_FRAME_L(l + 1); p_convert(Fp, args, l + 1, WB); }
            SEAM(p0 + 4);
        }
        if (IN(p0 + 6)) { PHASE_FRAME();
            pg8::Gemm g{(const pg8::bf16_t*)Y, (const pg8::bf16_t*)(WB + WB_OUT), M, DM, DM, DM, 1 << 30, 0};
            pg8::StaticOrder S; S.init(M, DM, F.G, (int)blockIdx.x);
            EpiResid E{XB, XL, SS + (size_t)(2 * l + 1) * M};
            pg8::gemm_phase<EpiResid, true>(F.lds, g, S, E);
            SEAM(p0 + 6);
        }
#pragma nounroll
        for (int hf = 0; hf < 2; ++hf) {
        if (IN(p0 + 8)) { PHASE_FRAME();
            const size_t ro = (size_t)hf * (M / 2);
            pg8::Gemm g{(const pg8::bf16_t*)(XB + ro * DM), (const pg8::bf16_t*)(WB + WB_GU), M / 2, 2 * FFN, DM, DM, 1 << 30, 0};
            pg8::StaticOrder S; S.init(M / 2, 2 * FFN, F.G, (int)blockIdx.x);
            EpiSwiglu E{PROJ + ro * FFN, SS + (size_t)(2 * l + 1) * M + ro};
            pg8::gemm_phase<EpiSwiglu, true>(F.lds, g, S, E);
            if (!MK_PER_PHASE_LAUNCH) xcd_barrier(bar);
        }
        if (IN(p0 + 9)) { PHASE_FRAME();
            const size_t ro = (size_t)hf * (M / 2);
            pg8::Gemm g{(const pg8::bf16_t*)(PROJ + ro * FFN), (const pg8::bf16_t*)(WB + WB_DN), M / 2, DM, FFN, FFN, 1 << 30, 0};
            pg8::StaticOrder S; S.init(M / 2, DM, F.G, (int)blockIdx.x);
            EpiResid E{XB + ro * DM, XL + ro * DM, SS + (size_t)(2 * l + 2) * M + ro};
            pg8::gemm_phase<EpiResid, true, true>(F.lds, g, S, E);
            if (hf == 1) SEAM(p0 + 9);
        }
        }
    }
    if (IN(41)) { PHASE_FRAME_L(0); p_final(Fp, XB, XL, OUT, args.in[14]); }
#undef IN
#undef SEAM
}

extern "C" void kernel_launch(void* const* d_in, const int* in_sizes, int n_in, void* d_out, int out_size, void* d_ws, size_t ws_size, hipStream_t stream) {
    static int grid = 0;
    if (grid == 0) {
        if (n_in != 15 || out_size != M * DM || ws_size < WS_END) { fprintf(stderr, "kernel_launch: unexpected shapes (n_in %d, out %d, ws %zu; need ws >= %zu); nothing launched\n", n_in, out_size, ws_size, (size_t)WS_END); grid = -1; return; }
        int dev = 0, cus = 0, per_cu = 0;
        if (hipGetDevice(&dev) != hipSuccess || hipDeviceGetAttribute(&cus, hipDeviceAttributeMultiprocessorCount, dev) != hipSuccess) { grid = -1; return; }
        if (hipFuncSetAttribute((const void*)fwd_kernel, hipFuncAttributeMaxDynamicSharedMemorySize, LDS_BYTES) != hipSuccess) { fprintf(stderr, "kernel_launch: hipFuncSetAttribute failed\n"); grid = -1; return; }
        if (hipOccupancyMaxActiveBlocksPerMultiprocessor(&per_cu, (const void*)fwd_kernel, 512, LDS_BYTES) != hipSuccess || per_cu < 1)
            fprintf(stderr, "kernel_launch: note: occupancy query reports %d workgroups per CU\n", per_cu);
        (void)hipGetLastError();
        grid = cus;
    }
    if (grid < 0) return;
    (void)in_sizes;
    if (hipMemsetAsync((char*)d_ws + WS_CTL, 0, CTL_ZERO_BYTES, stream) != hipSuccess) return;
    Args a{};
    for (int i = 0; i < 15; ++i) a.in[i] = (const float*)d_in[i];
    a.out = (float*)d_out; a.ws = (unsigned char*)d_ws;
    for (int i = 0; i < 64; ++i) a.invf128[i] = (double)powf(10000.0f, -(float)(2 * i) / 128.0f);
    for (int i = 0; i < 32; ++i) a.invf64[i] = (double)powf(10000.0f, -(float)(2 * i) / 64.0f);
#if MK_PER_PHASE_LAUNCH
    for (int p = 0; p < N_PHASES; ++p) { a.ph_lo = p; a.ph_hi = p + 1; hipLaunchKernelGGL(fwd_kernel, dim3(grid), dim3(512), LDS_BYTES, stream, a); }
#else
    a.ph_lo = 0; a.ph_hi = N_PHASES;
    hipLaunchKernelGGL(fwd_kernel, dim3(grid), dim3(512), LDS_BYTES, stream, a);
#endif
}
```
